# Optimizing an MI355X kernel written in HIP

```python
import jax, jax.numpy as jnp
from jax import lax
import numpy as np

D_MODEL = 1024
BATCH = 4
SEQ = 8192
DEPTH = 1

RET_HEADS = 4
RET_QK_DIM = 128
RET_V_DIM = 256
RET_CHUNK = 128
ROPE_BASE = 10000.0
SWA_Q_HEADS = 8
SWA_KV_HEADS = 2
SWA_HEAD_DIM = 64
SWA_WINDOW = 128
MOE_GROUPS = 4
MOE_EXPERTS_PER_GROUP = 8
MOE_TOP_K = 2
MOE_D_FF = 512
MOE_BLOCK = 128
NORM_EPS = 1e-6

RET_QK_W = RET_HEADS * RET_QK_DIM
RET_V_W = RET_HEADS * RET_V_DIM
SWA_Q_W = SWA_Q_HEADS * SWA_HEAD_DIM
SWA_KV_W = SWA_KV_HEADS * SWA_HEAD_DIM
IN_SPLITS = (RET_QK_W, RET_QK_W, RET_V_W, RET_V_W, SWA_Q_W, SWA_KV_W, SWA_KV_W, D_MODEL, D_MODEL)
IN_WIDTH = int(sum(IN_SPLITS))
IN_CUTS = tuple(int(c) for c in np.cumsum(IN_SPLITS)[:-1])
MOE_N_EXPERTS = MOE_GROUPS * MOE_EXPERTS_PER_GROUP

kernel_name = "hybrid_retention_swa_sink_hmoe_block"


def rmsnorm(x, g):
    x32 = x.astype(jnp.float32)
    r = lax.rsqrt(jnp.mean(x32 * x32, axis=-1, keepdims=True) + NORM_EPS)
    return (x32 * r).astype(x.dtype) * g


def rotary(x, pos):
    half = x.shape[-1] // 2
    inv = ROPE_BASE ** (-jnp.arange(half, dtype=jnp.float32) / half)
    ang = pos.astype(jnp.float32)[:, None] * inv[None, :]
    cos = jnp.cos(ang)[None, :, None, :]
    sin = jnp.sin(ang)[None, :, None, :]
    x1, x2 = x[..., :half], x[..., half:]
    return jnp.concatenate([x1 * cos - x2 * sin, x1 * sin + x2 * cos], axis=-1)


def retention_chunkwise(q, k, v):
    B, S, H, dk = q.shape
    dv = v.shape[-1]
    C = RET_CHUNK
    nC = S // C
    q = q.reshape(B, nC, C, H, dk)
    k = k.reshape(B, nC, C, H, dk) * (dk ** -0.5)
    v = v.reshape(B, nC, C, H, dv)
    log_g = jnp.log1p(-jnp.exp2(-5.0 - jnp.arange(H, dtype=jnp.float32)))
    idx = jnp.arange(C, dtype=jnp.float32)
    diff = idx[:, None] - idx[None, :]
    decay = jnp.where(diff >= 0, jnp.exp(log_g[:, None, None] * jnp.maximum(diff, 0.0)), 0.0)
    scores = jnp.einsum('bcqhd,bckhd->bchqk', q, k) * decay[None, None]
    intra = jnp.einsum('bchqk,bckhe->bcqhe', scores, v)
    k_dec = k * jnp.exp(log_g[None, :] * (C - 1 - idx)[:, None])[None, None, :, :, None]
    kv = jnp.einsum('bckhd,bckhe->cbhde', k_dec, v)
    chunk_decay = jnp.exp(log_g * C)[None, :, None, None]

    def step(R, kv_c):
        return chunk_decay * R + kv_c, R

    _, R_prev = lax.scan(step, jnp.zeros_like(kv[0]), kv)
    q_dec = q * jnp.exp(log_g[None, :] * (idx + 1.0)[:, None])[None, None, :, :, None]
    cross = jnp.einsum('bcqhd,cbhde->bcqhe', q_dec, R_prev)
    return (intra + cross).reshape(B, S, H, dv)


def swa_sink_attention(q, k, v, sinks):
    B, S, Hq, d = q.shape
    Hkv = k.shape[2]
    G = Hq // Hkv
    W = SWA_WINDOW
    nB = S // W
    qb = q.reshape(B, nB, W, Hkv, G, d)
    kb = k.reshape(B, nB, W, Hkv, d)
    vb = v.reshape(B, nB, W, Hkv, d)
    pad = jnp.zeros_like(kb[:, :1])
    k_ext = jnp.concatenate([jnp.concatenate([pad, kb[:, :-1]], axis=1), kb], axis=2)
    v_ext = jnp.concatenate([jnp.concatenate([pad, vb[:, :-1]], axis=1), vb], axis=2)
    s = jnp.einsum('bnqkgd,bnskd->bkgnqs', qb, k_ext).astype(jnp.float32) * (d ** -0.5)
    blk = jnp.arange(nB)[:, None, None]
    qpos = blk * W + jnp.arange(W)[None, :, None]
    kpos = (blk - 1) * W + jnp.arange(2 * W)[None, None, :]
    rel = qpos - kpos
    valid = (rel >= 0) & (rel < W) & (kpos >= 0)
    s = jnp.where(valid, s, -jnp.inf)
    sink = sinks.astype(jnp.float32).reshape(Hkv, G)[None, :, :, None, None, None]
    m = jnp.maximum(jnp.max(s, axis=-1, keepdims=True), sink)
    p = jnp.exp(s - m)
    denom = jnp.sum(p, axis=-1, keepdims=True) + jnp.exp(sink - m)
    p = (p / denom).astype(v.dtype)
    o = jnp.einsum('bkgnqs,bnskd->bnqkgd', p, v_ext)
    return o.reshape(B, S, Hq * d)


def hierarchical_moe(h, w_rg, b_rg, w_re, b_re, w_gate, w_up, w_down):
    N, D = h.shape
    E = MOE_EXPERTS_PER_GROUP
    K = MOE_TOP_K
    BLK = MOE_BLOCK
    group_probs = jax.nn.softmax((h @ w_rg).astype(jnp.float32) + b_rg, axis=-1)
    g_prob, g_idx = lax.top_k(group_probs, 1)
    e_logits = ((h @ w_re).astype(jnp.float32) + b_re).reshape(N, MOE_GROUPS, E)
    sel = jnp.take_along_axis(e_logits, g_idx[:, :, None], axis=1)[:, 0]
    top_logit, e_idx = lax.top_k(sel, K)
    e_w = jax.nn.softmax(top_logit, axis=-1) * g_prob
    expert_id = g_idx * E + e_idx
    A = N * K
    flat_e = expert_id.reshape(A)
    flat_tok = jnp.repeat(jnp.arange(N, dtype=jnp.int32), K)
    flat_w = e_w.reshape(A)
    order = jnp.argsort(flat_e)
    se, stok, sw = flat_e[order], flat_tok[order], flat_w[order]
    counts = jnp.zeros((MOE_N_EXPERTS,), jnp.int32).at[flat_e].add(1)
    starts = jnp.cumsum(counts) - counts
    padded = (counts + BLK - 1) // BLK * BLK
    pends = jnp.cumsum(padded)
    pstarts = pends - padded
    dest = pstarts[se] + jnp.arange(A, dtype=jnp.int32) - starts[se]
    P = A + MOE_N_EXPERTS * BLK
    n_blk = P // BLK
    row_tok = jnp.zeros((P,), jnp.int32).at[dest].set(stok)
    row_w = jnp.zeros((P,), h.dtype).at[dest].set(sw.astype(h.dtype))
    blk_expert = jnp.minimum(jnp.searchsorted(pends, jnp.arange(n_blk, dtype=jnp.int32) * BLK, side='right'),
                             MOE_N_EXPERTS - 1)
    xs = h[row_tok].reshape(n_blk, BLK, D)

    def expert_block(args):
        xb, e = args
        return (jax.nn.silu(xb @ w_gate[e]) * (xb @ w_up[e])) @ w_down[e]

    ys = lax.map(expert_block, (xs, blk_expert)).reshape(P, D)
    return jnp.zeros_like(h).at[row_tok].add(ys * row_w[:, None])


def setup_inputs(seed: int = 0) -> dict:
    key = jax.random.key(seed)
    ks = jax.random.split(key, 20)
    L, D = DEPTH, D_MODEL
    f32 = jnp.float32

    def nrm(k, shape, scale):
        return jax.random.normal(k, shape, f32) * scale

    return {
        "x": nrm(ks[0], (BATCH, SEQ, D), 1.0),
        "norm_mix_g": 1.0 + nrm(ks[1], (L, D), 0.02),
        "w_in": nrm(ks[2], (L, D, IN_WIDTH), D ** -0.5),
        "ret_gn_g": 1.0 + nrm(ks[3], (L, RET_HEADS, RET_V_DIM), 0.02),
        "w_ret_o": nrm(ks[4], (L, RET_V_W, D), RET_V_W ** -0.5),
        "q_norm_g": 1.0 + nrm(ks[5], (L, SWA_HEAD_DIM), 0.02),
        "k_norm_g": 1.0 + nrm(ks[6], (L, SWA_HEAD_DIM), 0.02),
        "sinks": nrm(ks[7], (L, SWA_Q_HEADS), 0.5),
        "w_swa_o": nrm(ks[8], (L, SWA_Q_W, D), SWA_Q_W ** -0.5),
        "w_out": nrm(ks[9], (L, D, D), D ** -0.5),
        "norm_ffn_g": 1.0 + nrm(ks[10], (L, D), 0.02),
        "w_router_group": nrm(ks[11], (L, D, MOE_GROUPS), D ** -0.5),
        "b_router_group": nrm(ks[12], (L, MOE_GROUPS), 0.01),
        "w_router_expert": nrm(ks[13], (L, D, MOE_N_EXPERTS), D ** -0.5),
        "b_router_expert": nrm(ks[14], (L, MOE_N_EXPERTS), 0.01),
        "w_gate": nrm(ks[15], (L, MOE_N_EXPERTS, D, MOE_D_FF), D ** -0.5),
        "w_up": nrm(ks[16], (L, MOE_N_EXPERTS, D, MOE_D_FF), D ** -0.5),
        "w_down": nrm(ks[17], (L, MOE_N_EXPERTS, MOE_D_FF, D), MOE_D_FF ** -0.5),
    }


def reference(x, norm_mix_g, w_in, ret_gn_g, w_ret_o, q_norm_g, k_norm_g, sinks, w_swa_o, w_out,
              norm_ffn_g, w_router_group, b_router_group, w_router_expert, b_router_expert,
              w_gate, w_up, w_down):
    B, S, D = x.shape
    pos = jnp.arange(S, dtype=jnp.int32)
    for l in range(DEPTH):
        h = rmsnorm(x, norm_mix_g[l])
        proj = h @ w_in[l]
        rq, rk, rv, rg, sq, sk, sv, gate_a, gate_b = jnp.split(proj, IN_CUTS, axis=-1)
        rq = rotary(rq.astype(jnp.float32).reshape(B, S, RET_HEADS, RET_QK_DIM), pos)
        rk = rotary(rk.astype(jnp.float32).reshape(B, S, RET_HEADS, RET_QK_DIM), pos)
        rv = rv.astype(jnp.float32).reshape(B, S, RET_HEADS, RET_V_DIM)
        ret = retention_chunkwise(rq, rk, rv)
        mu = jnp.mean(ret, axis=-1, keepdims=True)
        var = jnp.mean(jnp.square(ret - mu), axis=-1, keepdims=True)
        ret = ((ret - mu) * lax.rsqrt(var + NORM_EPS)).astype(x.dtype) * ret_gn_g[l]
        ret = jax.nn.silu(rg) * ret.reshape(B, S, RET_V_W)
        y_a = ret @ w_ret_o[l]
        sq = rmsnorm(sq.reshape(B, S, SWA_Q_HEADS, SWA_HEAD_DIM), q_norm_g[l])
        sk = rmsnorm(sk.reshape(B, S, SWA_KV_HEADS, SWA_HEAD_DIM), k_norm_g[l])
        sv = sv.reshape(B, S, SWA_KV_HEADS, SWA_HEAD_DIM)
        y_b = swa_sink_attention(sq, sk, sv, sinks[l]) @ w_swa_o[l]
        merged = jax.nn.sigmoid(gate_a) * y_a + jax.nn.sigmoid(gate_b) * y_b
        x = x + merged @ w_out[l]
        h2 = rmsnorm(x, norm_ffn_g[l]).reshape(B * S, D)
        moe = hierarchical_moe(h2, w_router_group[l], b_router_group[l], w_router_expert[l],
                               b_router_expert[l], w_gate[l], w_up[l], w_down[l])
        x = x + moe.reshape(B, S, D)
    return x
```

```cpp
#include <hip/hip_runtime.h>
#include <hip/hip_cooperative_groups.h>
#include <cstdio>
#include <cstdint>
namespace cg = cooperative_groups;
#ifndef PHMASK
#define PHMASK 0xFFFF
#endif

#define LAS __attribute__((address_space(3)))
typedef unsigned short bf16_t;
typedef short bf16x8 __attribute__((ext_vector_type(8)));
typedef float f32x4 __attribute__((ext_vector_type(4)));
typedef float f32x16 __attribute__((ext_vector_type(16)));
typedef unsigned u32x4 __attribute__((ext_vector_type(4)));
typedef unsigned u32x2 __attribute__((ext_vector_type(2)));
typedef float f32x2_t __attribute__((ext_vector_type(2)));
typedef __bf16 bf16x2_t __attribute__((ext_vector_type(2)));

constexpr int DM = 1024, SEQ = 8192, NTOK = 32768, INW = 5888;
constexpr int NE = 32, DFF = 512;
constexpr float EPS = 1e-6f;
constexpr int LCAP = 32768;

constexpr size_t MiB = 1u << 20;
constexpr size_t WS_CTL = 0;
constexpr size_t WS_WIN = 1 * MiB;
constexpr size_t WS_WRETO = 13 * MiB;
constexpr size_t WS_WSWAO = 15 * MiB;
constexpr size_t WS_WOUT = 16 * MiB;
constexpr size_t WS_WR = 18 * MiB;
constexpr size_t WS_ROT = 19 * MiB;
constexpr size_t WS_SS = 23 * MiB;
constexpr size_t WS_RT = 25 * MiB;
constexpr size_t WS_H = 26 * MiB;
constexpr size_t WS_QR = 90 * MiB;
constexpr size_t WS_KR = 122 * MiB;
constexpr size_t WS_KDT = 154 * MiB;
constexpr size_t WS_VT = 186 * MiB;
constexpr size_t WS_GS = 250 * MiB;
constexpr size_t WS_SQ = 314 * MiB;
constexpr size_t WS_SK = 346 * MiB;
constexpr size_t WS_SVT = 354 * MiB;
constexpr size_t WS_RP = 362 * MiB;
constexpr size_t WS_SW = 426 * MiB;
constexpr size_t WS_LTOK = 458 * MiB;
constexpr size_t WS_LW = 466 * MiB;
constexpr size_t WS_END = 474 * MiB;

constexpr int LDS_BYTES = 147456;
constexpr int LDS_TAB = 131072;

#define DI __device__ __forceinline__
DI unsigned pk2(float lo, float hi) { f32x2_t v = {lo, hi}; bf16x2_t b = __builtin_convertvector(v, bf16x2_t); return __builtin_bit_cast(unsigned, b); }
DI float bflo(unsigned w) { return __uint_as_float(w << 16); }
DI float bfhi(unsigned w) { return __uint_as_float(w & 0xffff0000u); }
DI bf16_t f2bf(float f) { return (bf16_t)(pk2(f, 0.f) & 0xffffu); }
DI float wave_sum(float v) {
#pragma unroll
    for (int o = 1; o < 64; o <<= 1) v += __shfl_xor(v, o);
    return v;
}
DI float sigmoidf_(float v) { return 1.0f / (1.0f + __expf(-v)); }
DI float siluf_(float v) { return v / (1.0f + __expf(-v)); }
#define MFMA32(a, b, c) __builtin_amdgcn_mfma_f32_32x32x16_bf16((a), (b), (c), 0, 0, 0)
DI int crow(int reg, int h) { return (reg & 3) + 8 * (reg >> 2) + 4 * h; }
DI bf16x8 pack8(const f32x16& x, int s) {
    u32x4 p; p.x = pk2(x[8 * s], x[8 * s + 1]); p.y = pk2(x[8 * s + 2], x[8 * s + 3]); p.z = pk2(x[8 * s + 4], x[8 * s + 5]); p.w = pk2(x[8 * s + 6], x[8 * s + 7]);
    return __builtin_bit_cast(bf16x8, p);
}
DI float lg2gamma(int h) { return h == 0 ? -0.04580368961312479f : h == 1 ? -0.02272007650008353f : h == 2 ? -0.011315313227834146f : -0.005646563141142063f; }

DI int colmap_std(int p) { const int bj = p >> 7, wc = (p >> 5) & 3, n = (p >> 4) & 1, fq = (p >> 2) & 3, j = p & 3; return 64 * wc + 32 * bj + 8 * fq + 4 * n + j; }
DI int colmap_rot(int p) { const int bj = p >> 7, wc = (p >> 5) & 3, n = (p >> 4) & 1, fq = (p >> 2) & 3, j = p & 3; return 128 * bj + 64 * n + 16 * wc + 4 * fq + j; }

namespace pg8 {
constexpr int BM = 256, BK = 64, HALF = 128, HTB = HALF * BK * 2, STAGE_BYTES = 8 * HTB, NXCD = 8, WGM = 8;
DI int lds_byte(int r, int c) { const int st = (r >> 4) * 2 + (c >> 5), rr = r & 15, cc = c & 31, ob = rr * 64 + cc * 2; return st * 1024 + (ob ^ (((ob >> 9) & 1) << 5)); }
DI void stage_rc(int b, int& R, int& C) { const int st = b / 1024, sb = b % 1024, swz = sb ^ (((sb >> 9) & 1) << 5); R = (st >> 1) * 16 + swz / 64; C = (st & 1) * 32 + (swz % 64) / 2; }

struct Unit { int pm, pn, g, aux; };

template <class Epi, class Sched>
DI void gemm_phase(LAS unsigned char* lds, const char* Abase, const int K, const Sched& S, const Epi& E) {
    const int tid = threadIdx.x, wid = __builtin_amdgcn_readfirstlane(tid >> 6), lane = tid & 63, wr = wid >> 2, wc = wid & 3, fr = lane & 15, fq = lane >> 4;
    const int nt = K / BK;
    int Rr[2], Cc[2]; unsigned voffB[2];
#pragma unroll
    for (int i = 0; i < 2; ++i) { stage_rc(tid * 16 + i * 8192, Rr[i], Cc[i]); voffB[i] = (unsigned)(Rr[i] * K + Cc[i]) * 2u; }
    const size_t kstep = (size_t)(BK * 2);
    const size_t hstep = (size_t)HALF * K * 2;
    const unsigned ldsw = (unsigned)wid * 1024u;
    const int aoff = lds_byte(wr * 64 + fr, fq * 8), boff = lds_byte(wc * 32 + fr, fq * 8);
#define PG8_SA(b, h) (((b) * 2 + (h)) * HTB)
#define PG8_SB(b, h) ((4 + (b) * 2 + (h)) * HTB)
#define PG8_STAGE(bufoff, gbase, voff) do { _Pragma("unroll") for (int _i = 0; _i < 2; ++_i) \
        __builtin_amdgcn_global_load_lds((const unsigned*)((const char*)(gbase) + (voff)[_i]), (LAS unsigned*)(lds + (bufoff) + ldsw + _i * 8192), 16, 0, 0); } while (0)
#define PG8_LDA(dst, b, h) do { _Pragma("unroll") for (int m = 0; m < 4; ++m) _Pragma("unroll") for (int k = 0; k < 2; ++k) dst[m][k] = *(const LAS bf16x8*)(lds + PG8_SA(b, h) + aoff + m * 2048 + k * 1024); } while (0)
#define PG8_LDB(dst, b, h) do { _Pragma("unroll") for (int n = 0; n < 2; ++n) _Pragma("unroll") for (int k = 0; k < 2; ++k) dst[n][k] = *(const LAS bf16x8*)(lds + PG8_SB(b, h) + boff + n * 2048 + k * 1024); } while (0)
#define PG8_MMA(ai, bj, At, Bt) do { __builtin_amdgcn_s_setprio(1); _Pragma("unroll") for (int m = 0; m < 4; ++m) _Pragma("unroll") for (int n = 0; n < 2; ++n) _Pragma("unroll") for (int k = 0; k < 2; ++k) \
        acc[ai][bj][m][n] = __builtin_amdgcn_mfma_f32_16x16x32_bf16(Bt[n][k], At[m][k], acc[ai][bj][m][n], 0, 0, 0); __builtin_amdgcn_s_setprio(0); } while (0)
#define PG8_WAIT_V(n) asm volatile("s_waitcnt vmcnt(" #n ")" ::: "memory")
#define PG8_WAIT_L(n) asm volatile("s_waitcnt lgkmcnt(" #n ")" ::: "memory")
#define PG8_BAR __builtin_amdgcn_s_barrier()
#define PG8_SCHED __builtin_amdgcn_sched_barrier(0)
    Unit cur, nxt; int ui = 0;
    if (!S.next(0, cur)) return;
    f32x4 acc[2][2][4][2];
#pragma unroll
    for (int a = 0; a < 2; ++a)
#pragma unroll
        for (int b = 0; b < 2; ++b)
#pragma unroll
            for (int m = 0; m < 4; ++m)
#pragma unroll
                for (int n = 0; n < 2; ++n) acc[a][b][m][n] = (f32x4){0.f, 0.f, 0.f, 0.f};
    bf16x8 At[4][2], B0[2][2], B1[2][2];
    unsigned co[2][2], no[2][2];
    S.aoffs(cur, Rr, Cc, co);
    const char* cB = S.bbase(cur);
    PG8_STAGE(PG8_SB(0, 0), cB, voffB); PG8_STAGE(PG8_SB(0, 1), cB + hstep, voffB); PG8_STAGE(PG8_SA(0, 0), Abase, co[0]); PG8_STAGE(PG8_SA(0, 1), Abase, co[1]);
    if (wr == 1) PG8_BAR;
    PG8_WAIT_V(2); PG8_BAR;
    PG8_STAGE(PG8_SB(1, 0), cB + kstep, voffB); PG8_STAGE(PG8_SA(1, 0), Abase + kstep, co[0]); PG8_STAGE(PG8_SB(1, 1), cB + hstep + kstep, voffB);
    PG8_WAIT_V(6); PG8_BAR;
    for (;;) {
        const bool has_next = S.next(ui + 1, nxt);
        const char* nB = has_next ? S.bbase(nxt) : cB;
        if (has_next) S.aoffs(nxt, Rr, Cc, no);
        else { no[0][0] = co[0][0]; no[0][1] = co[0][1]; no[1][0] = co[1][0]; no[1][1] = co[1][1]; }
        for (int t = 0; t < nt; t += 2) {
            const bool last = (t == nt - 2);
            const char* a1 = Abase + (size_t)(t + 1) * kstep;
            const char* a2 = last ? Abase : Abase + (size_t)(t + 2) * kstep; const char* b2 = last ? nB : cB + (size_t)(t + 2) * kstep;
            const char* a3 = a2 + kstep; const char* b3 = b2 + kstep;
            unsigned o2[2][2];
            o2[0][0] = last ? no[0][0] : co[0][0]; o2[0][1] = last ? no[0][1] : co[0][1]; o2[1][0] = last ? no[1][0] : co[1][0]; o2[1][1] = last ? no[1][1] : co[1][1];
            PG8_LDB(B0, 0, 0); PG8_LDB(B1, 0, 1); PG8_SCHED; PG8_LDA(At, 0, 0); PG8_STAGE(PG8_SA(1, 1), a1, co[1]);
            PG8_WAIT_V(8); PG8_WAIT_L(0); PG8_BAR; PG8_MMA(0, 0, At, B0); PG8_MMA(0, 1, At, B1); PG8_BAR; PG8_SCHED;
            PG8_LDA(At, 0, 1); PG8_STAGE(PG8_SB(0, 0), b2, voffB); PG8_STAGE(PG8_SB(0, 1), b2 + hstep, voffB); PG8_STAGE(PG8_SA(0, 0), a2, o2[0]);
            PG8_WAIT_V(8); PG8_WAIT_L(0); PG8_BAR; PG8_MMA(1, 0, At, B0); PG8_MMA(1, 1, At, B1); PG8_BAR; PG8_SCHED;
            PG8_LDB(B0, 1, 0); PG8_LDB(B1, 1, 1); PG8_SCHED; PG8_LDA(At, 1, 0); PG8_STAGE(PG8_SA(0, 1), a2, o2[1]);
            PG8_WAIT_V(8); PG8_WAIT_L(0); PG8_BAR; PG8_MMA(0, 0, At, B0); PG8_MMA(0, 1, At, B1); PG8_BAR; PG8_SCHED;
            PG8_LDA(At, 1, 1); PG8_STAGE(PG8_SB(1, 0), b3, voffB); PG8_STAGE(PG8_SB(1, 1), b3 + hstep, voffB); PG8_STAGE(PG8_SA(1, 0), a3, o2[0]);
            PG8_WAIT_V(8); PG8_WAIT_L(0); PG8_BAR; PG8_MMA(1, 0, At, B0); PG8_MMA(1, 1, At, B1); PG8_BAR; PG8_SCHED;
        }
        if (wr == 0) PG8_BAR;
        { int fr_ = fr, fq_ = fq; asm volatile("" : "+v"(fr_), "+v"(fq_));
          E(acc, cur, wr, wc, fr_, fq_); }
        if (!has_next) break;
#pragma unroll
        for (int a = 0; a < 2; ++a)
#pragma unroll
            for (int b = 0; b < 2; ++b)
#pragma unroll
                for (int m = 0; m < 4; ++m)
#pragma unroll
                    for (int n = 0; n < 2; ++n) acc[a][b][m][n] = (f32x4){0.f, 0.f, 0.f, 0.f};
        cur = nxt; cB = nB; co[0][0] = no[0][0]; co[0][1] = no[0][1]; co[1][0] = no[1][0]; co[1][1] = no[1][1]; ++ui;
        if (wr == 1) PG8_BAR;
    }
    PG8_WAIT_V(0);
    PG8_BAR;
#undef PG8_SA
#undef PG8_SB
#undef PG8_STAGE
#undef PG8_LDA
#undef PG8_LDB
#undef PG8_MMA
#undef PG8_WAIT_V
#undef PG8_WAIT_L
#undef PG8_BAR
#undef PG8_SCHED
}

struct DenseOrder {
    int nM, nN, nwg, G, c, K; const char* Bt;
    DI void init(int M, int N, int K_, int G_, int c_, const void* Bt_) { nM = M / BM; nN = N / BM; nwg = nM * nN; G = G_; c = c_; K = K_; Bt = (const char*)Bt_; }
    DI bool next(int i, Unit& u) const {
        const long L = (long)i * G + c; if (L >= nwg) return false;
        int wgid = (int)L; { const int q = nwg / NXCD, r = nwg % NXCD, xcd = wgid % NXCD, off = wgid / NXCD; wgid = (xcd < r ? xcd * (q + 1) : r * (q + 1) + (xcd - r) * q) + off; }
        const int nig = WGM * nN, gid = wgid / nig, fm = gid * WGM, gsz = (nM - fm) < WGM ? (nM - fm) : WGM;
        u.pm = fm + ((wgid % nig) % gsz); u.pn = (wgid % nig) / gsz; u.g = 0; u.aux = 0; return true;
    }
    DI const char* bbase(const Unit& u) const { return Bt + (size_t)u.pn * BM * K * 2; }
    DI void aoffs(const Unit& u, const int (&R)[2], const int (&C)[2], unsigned (&off)[2][2]) const {
#pragma unroll
        for (int h = 0; h < 2; ++h)
#pragma unroll
            for (int i = 0; i < 2; ++i) off[h][i] = (unsigned)((u.pm * BM + h * HALF + R[i]) * K + C[i]) * 2u;
    }
};

struct GroupOrder {
    const LAS int* tab; int g0, ng, G, c, K, nunits; const char* Bt; size_t bstride;
    const int* ltok; bool gather;
    DI void init(const LAS int* tab_, int g0_, int ng_, int K_, int G_, int c_, const void* Bt_, size_t bstride_, const int* ltok_, bool gather_) {
        tab = tab_; g0 = g0_; ng = ng_; K = K_; G = G_; c = c_; Bt = (const char*)Bt_; bstride = bstride_; ltok = ltok_; gather = gather_;
        nunits = 4 * (tab[64 + g0 + ng] - tab[64 + g0]);
    }
    DI bool next(int i, Unit& u) const {
        const long L = (long)i * G + c; if (L >= nunits) return false;
        int wgid = (int)L; { const int nwg = nunits, q = nwg / NXCD, r = nwg % NXCD, xcd = wgid % NXCD, off = wgid / NXCD; wgid = (xcd < r ? xcd * (q + 1) : r * (q + 1) + (xcd - r) * q) + off; }
        const int T = tab[64 + g0] + (wgid >> 2);
        int g = g0;
        for (int k = g0; k < g0 + ng; ++k) if (tab[64 + k + 1] <= T) g = k + 1;
        u.g = __builtin_amdgcn_readfirstlane(g); u.aux = __builtin_amdgcn_readfirstlane(T - tab[64 + g]); u.pm = __builtin_amdgcn_readfirstlane((tab[192 + g] >> 8) + u.aux); u.pn = wgid & 3; return true;
    }
    DI const char* bbase(const Unit& u) const { return Bt + (size_t)(u.g & 31) * bstride + (size_t)u.pn * BM * K * 2; }
    DI void aoffs(const Unit& u, const int (&R)[2], const int (&C)[2], unsigned (&off)[2][2]) const {
        if (gather) {
            const int cnt = __builtin_amdgcn_readfirstlane(tab[u.g]);
#pragma unroll
            for (int h = 0; h < 2; ++h)
#pragma unroll
                for (int i = 0; i < 2; ++i) { const int rank = u.aux * BM + h * HALF + R[i]; const int tok = rank < cnt ? ltok[(size_t)u.g * LCAP + rank] : 0; off[h][i] = (unsigned)(tok * K + C[i]) * 2u; }
        } else {
#pragma unroll
            for (int h = 0; h < 2; ++h)
#pragma unroll
                for (int i = 0; i < 2; ++i) off[h][i] = (unsigned)((u.pm * BM + h * HALF + R[i]) * K + C[i]) * 2u;
        }
    }
};
}
using pg8::Unit;

#define EPI_ROWS(ai, m) (u.pm * 256 + (ai) * 128 + wr * 64 + (m) * 16 + fr)
typedef f32x4 Acc[2][2][4][2];

DI void store8(bf16_t* p, f32x4 v0, f32x4 v1) { u32x4 w; w.x = pk2(v0[0], v0[1]); w.y = pk2(v0[2], v0[3]); w.z = pk2(v1[0], v1[1]); w.w = pk2(v1[2], v1[3]); *(u32x4*)p = w; }
template <bool ISK> DI void epi_rot(const Acc& acc, const Unit& u, int wr, int wc, int fr, int fq, bf16_t* O, bf16_t* KdT, const float* rcos, const float* rsin, int hb) {
    const float sc = ISK ? 0.08838834764831845f : 1.0f;
    const int i0 = 16 * wc + 4 * fq;
#pragma unroll
    for (int ai = 0; ai < 2; ++ai)
#pragma unroll
        for (int m = 0; m < 4; ++m) {
            const int row = EPI_ROWS(ai, m), pos = row & (SEQ - 1), b = row >> 13;
            const f32x4 c4 = *(const f32x4*)(rcos + pos * 64 + i0), s4 = *(const f32x4*)(rsin + pos * 64 + i0);
#pragma unroll
            for (int bj = 0; bj < 2; ++bj) {
                const int head = hb + bj;
                const f32x4 x1 = acc[ai][bj][m][0], x2 = acc[ai][bj][m][1];
                const f32x4 o1 = (x1 * c4 - x2 * s4) * sc, o2 = (x1 * s4 + x2 * c4) * sc;
                bf16_t* op = O + (size_t)row * 512 + head * 128 + i0;
                u32x2 w1, w2; w1.x = pk2(o1[0], o1[1]); w1.y = pk2(o1[2], o1[3]); w2.x = pk2(o2[0], o2[1]); w2.y = pk2(o2[2], o2[3]);
                *(u32x2*)op = w1; *(u32x2*)(op + 64) = w2;
                if (ISK) {
                    const float dec = __builtin_amdgcn_exp2f((float)(127 - (pos & 127)) * lg2gamma(head));
                    bf16_t* tp = KdT + ((size_t)((b * 4 + head) * 128 + i0)) * SEQ + pos;
                    tp[0] = f2bf(o1[0] * dec); tp[(size_t)1 * SEQ] = f2bf(o1[1] * dec); tp[(size_t)2 * SEQ] = f2bf(o1[2] * dec); tp[(size_t)3 * SEQ] = f2bf(o1[3] * dec);
                    tp[(size_t)64 * SEQ] = f2bf(o2[0] * dec); tp[(size_t)65 * SEQ] = f2bf(o2[1] * dec); tp[(size_t)66 * SEQ] = f2bf(o2[2] * dec); tp[(size_t)67 * SEQ] = f2bf(o2[3] * dec);
                }
            }
            asm volatile("" ::: "memory");
        }
}
DI void epi_tr(const Acc& acc, const Unit& u, int wr, int wc, int fr, int fq, bf16_t* TP, int nrow_b, int rowoff, int bjmul) {
    char* tb = (char*)TP;
#pragma unroll
    for (int ai = 0; ai < 2; ++ai)
#pragma unroll
        for (int m = 0; m < 4; ++m) {
            const int row = EPI_ROWS(ai, m), pos = row & (SEQ - 1), b = row >> 13;
            const unsigned o0 = (unsigned)((b * nrow_b + rowoff + 8 * fq) * SEQ + pos) * 2u;
#pragma unroll
            for (int bj = 0; bj < 2; ++bj)
#pragma unroll
                for (int n = 0; n < 2; ++n) {
                    const unsigned o = o0 + (unsigned)((bjmul * bj + 4 * n) * SEQ) * 2u;
                    const f32x4 v = acc[ai][bj][m][n];
                    *(bf16_t*)(tb + o) = f2bf(v[0]); *(bf16_t*)(tb + o + 2u * SEQ) = f2bf(v[1]); *(bf16_t*)(tb + o + 4u * SEQ) = f2bf(v[2]); *(bf16_t*)(tb + o + 6u * SEQ) = f2bf(v[3]);
                }
            asm volatile("" ::: "memory");
        }
}
template <bool SIL> DI void epi_gate(const Acc& acc, const Unit& u, int wr, int wc, int fr, int fq, bf16_t* O, int cb) {
#pragma unroll
    for (int ai = 0; ai < 2; ++ai)
#pragma unroll
        for (int m = 0; m < 4; ++m) {
            const int row = EPI_ROWS(ai, m);
#pragma unroll
            for (int bj = 0; bj < 2; ++bj) {
                f32x4 v0 = acc[ai][bj][m][0], v1 = acc[ai][bj][m][1];
                if (SIL) { v0 = (f32x4){siluf_(v0[0]), siluf_(v0[1]), siluf_(v0[2]), siluf_(v0[3])}; v1 = (f32x4){siluf_(v1[0]), siluf_(v1[1]), siluf_(v1[2]), siluf_(v1[3])}; }
                else { v0 = (f32x4){sigmoidf_(v0[0]), sigmoidf_(v0[1]), sigmoidf_(v0[2]), sigmoidf_(v0[3])}; v1 = (f32x4){sigmoidf_(v1[0]), sigmoidf_(v1[1]), sigmoidf_(v1[2]), sigmoidf_(v1[3])}; }
                store8(O + (size_t)row * 1024 + cb + 64 * wc + 32 * bj + 8 * fq, v0, v1);
            }
            asm volatile("" ::: "memory");
        }
}
DI void epi_qknorm(const Acc& acc, const Unit& u, int wr, int wc, int fr, int fq, bf16_t* O, int pitch, int coff, const float* gw, float sc) {
    const f32x4 g00 = *(const f32x4*)(gw + 8 * fq) * sc, g01 = *(const f32x4*)(gw + 8 * fq + 4) * sc, g10 = *(const f32x4*)(gw + 32 + 8 * fq) * sc, g11 = *(const f32x4*)(gw + 32 + 8 * fq + 4) * sc;
#pragma unroll
    for (int ai = 0; ai < 2; ++ai)
#pragma unroll
        for (int m = 0; m < 4; ++m) {
            const int row = EPI_ROWS(ai, m);
            float ss = 0.f;
#pragma unroll
            for (int bj = 0; bj < 2; ++bj)
#pragma unroll
                for (int n = 0; n < 2; ++n) { const f32x4 v = acc[ai][bj][m][n]; ss += (v[0] * v[0] + v[1] * v[1]) + (v[2] * v[2] + v[3] * v[3]); }
            ss += __shfl_xor(ss, 16); ss += __shfl_xor(ss, 32);
            const float r = 1.0f / sqrtf(ss * (1.0f / 64.0f) + EPS);
            bf16_t* op = O + (size_t)row * pitch + coff + 8 * fq;
            store8(op, acc[ai][0][m][0] * r * g00, acc[ai][0][m][1] * r * g01);
            store8(op + 32, acc[ai][1][m][0] * r * g10, acc[ai][1][m][1] * r * g11);
            asm volatile("" ::: "memory");
        }
}
struct EpiProj {
    bf16_t *Qr, *Kr, *KdT, *VT, *Gs, *SQ, *SK, *SVT, *GA, *GB; const float *rcos, *rsin, *qng, *kng;
    DI void operator()(const Acc& acc, const Unit& u, int wr, int wc, int fr, int fq) const {
        const int pn = u.pn;
        if (pn < 2) epi_rot<false>(acc, u, wr, wc, fr, fq, Qr, nullptr, rcos, rsin, 2 * pn);
        else if (pn < 4) epi_rot<true>(acc, u, wr, wc, fr, fq, Kr, KdT, rcos, rsin, 2 * (pn - 2));
        else if (pn < 8) epi_tr(acc, u, wr, wc, fr, fq, VT, 1024, (pn - 4) * 256 + 64 * wc, 32);
        else if (pn < 12) epi_gate<true>(acc, u, wr, wc, fr, fq, Gs, (pn - 8) * 256);
        else if (pn < 14) epi_qknorm(acc, u, wr, wc, fr, fq, SQ, 512, ((pn - 12) * 4 + wc) * 64, qng, 0.125f);
        else if (pn == 14) {
            if (wc < 2) epi_qknorm(acc, u, wr, wc, fr, fq, SK, 128, wc * 64, kng, 1.0f);
            else epi_tr(acc, u, wr, wc, fr, fq, SVT, 128, (wc - 2) * 64, 32);
        }
        else if (pn < 19) epi_gate<false>(acc, u, wr, wc, fr, fq, GA, (pn - 15) * 256);
        else epi_gate<false>(acc, u, wr, wc, fr, fq, GB, (pn - 19) * 256);
    }
};

template <int MODE> struct EpiMerge {
    const bf16_t* G; bf16_t* T; bf16_t* MG;
    DI void operator()(const Acc& acc, const Unit& u, int wr, int wc, int fr, int fq) const {
#pragma unroll
        for (int ai = 0; ai < 2; ++ai)
#pragma unroll
            for (int m = 0; m < 4; ++m) {
                const int row = EPI_ROWS(ai, m);
#pragma unroll
                for (int bj = 0; bj < 2; ++bj) {
                    const size_t o = (size_t)row * 1024 + u.pn * 256 + 64 * wc + 32 * bj + 8 * fq;
                    const u32x4 g = *(const u32x4*)(G + o);
                    const f32x4 a0 = acc[ai][bj][m][0], a1 = acc[ai][bj][m][1];
                    float v[8] = {bflo(g.x) * a0[0], bfhi(g.x) * a0[1], bflo(g.y) * a0[2], bfhi(g.y) * a0[3], bflo(g.z) * a1[0], bfhi(g.z) * a1[1], bflo(g.w) * a1[2], bfhi(g.w) * a1[3]};
                    if (MODE == 1) { const u32x4 t = *(const u32x4*)(T + o);
                        v[0] += bflo(t.x); v[1] += bfhi(t.x); v[2] += bflo(t.y); v[3] += bfhi(t.y); v[4] += bflo(t.z); v[5] += bfhi(t.z); v[6] += bflo(t.w); v[7] += bfhi(t.w); }
                    u32x4 w; w.x = pk2(v[0], v[1]); w.y = pk2(v[2], v[3]); w.z = pk2(v[4], v[5]); w.w = pk2(v[6], v[7]);
                    *(u32x4*)((MODE == 0 ? T : MG) + o) = w;
                }
            }
    }
};

struct EpiOut {
    const float* x; float* out; bf16_t* XG2; float* SS; const float* g2;
    DI void operator()(const Acc& acc, const Unit& u, int wr, int wc, int fr, int fq) const {
        f32x4 gv[2][2];
#pragma unroll
        for (int bj = 0; bj < 2; ++bj)
#pragma unroll
            for (int n = 0; n < 2; ++n) gv[bj][n] = *(const f32x4*)(g2 + u.pn * 256 + 64 * wc + 32 * bj + 8 * fq + 4 * n);
#pragma unroll
        for (int ai = 0; ai < 2; ++ai)
#pragma unroll
            for (int m = 0; m < 4; ++m) {
                const int row = EPI_ROWS(ai, m);
                float ss = 0.f;
#pragma unroll
                for (int bj = 0; bj < 2; ++bj) {
                    const size_t o = (size_t)row * 1024 + u.pn * 256 + 64 * wc + 32 * bj + 8 * fq;
                    const f32x4 x0 = *(const f32x4*)(x + o) + acc[ai][bj][m][0], x1 = *(const f32x4*)(x + o + 4) + acc[ai][bj][m][1];
                    *(f32x4*)(out + o) = x0; *(f32x4*)(out + o + 4) = x1;
                    ss += (x0[0] * x0[0] + x0[1] * x0[1]) + (x0[2] * x0[2] + x0[3] * x0[3]) + (x1[0] * x1[0] + x1[1] * x1[1]) + (x1[2] * x1[2] + x1[3] * x1[3]);
                    const f32x4 y0 = x0 * gv[bj][0], y1 = x1 * gv[bj][1];
                    u32x4 w; w.x = pk2(y0[0], y0[1]); w.y = pk2(y0[2], y0[3]); w.z = pk2(y1[0], y1[1]); w.w = pk2(y1[2], y1[3]);
                    *(u32x4*)(XG2 + o) = w;
                }
                ss += __shfl_xor(ss, 16); ss += __shfl_xor(ss, 32);
                if (fq == 0) SS[(size_t)row * 16 + u.pn * 4 + wc] = ss;
            }
    }
};

struct EpiRouter {
    float* LOG;
    DI void operator()(const Acc& acc, const Unit& u, int wr, int wc, int fr, int fq) const {
        if (wc != 0) return;
#pragma unroll
        for (int ai = 0; ai < 2; ++ai)
#pragma unroll
            for (int m = 0; m < 4; ++m) {
                const int row = EPI_ROWS(ai, m);
#pragma unroll
                for (int bj = 0; bj < 2; ++bj) { float* p = LOG + (size_t)row * 64 + 32 * bj + 8 * fq; *(f32x4*)p = acc[ai][bj][m][0]; *(f32x4*)(p + 4) = acc[ai][bj][m][1]; }
            }
    }
};

struct EpiUp {
    bf16_t* HM; const LAS int* tab; const int* ltok; const float* rt;
    DI void operator()(const Acc& acc, const Unit& u, int wr, int wc, int fr, int fq) const {
        const int cnt = tab[u.g];
#pragma unroll
        for (int ai = 0; ai < 2; ++ai)
#pragma unroll
            for (int m = 0; m < 4; ++m) {
                const int lr = ai * 128 + wr * 64 + m * 16 + fr, rank = u.aux * 256 + lr;
                if (rank < cnt) {
                    const int tok = ltok[(size_t)u.g * LCAP + rank]; const float r = rt[tok];
                    float v[8];
#pragma unroll
                    for (int n = 0; n < 2; ++n)
#pragma unroll
                        for (int j = 0; j < 4; ++j) { const float g = acc[ai][0][m][n][j] * r, up = acc[ai][1][m][n][j] * r; v[4 * n + j] = siluf_(g) * up; }
                    u32x4 w; w.x = pk2(v[0], v[1]); w.y = pk2(v[2], v[3]); w.z = pk2(v[4], v[5]); w.w = pk2(v[6], v[7]);
                    *(u32x4*)(HM + (size_t)(u.pm * 256 + lr) * DFF + u.pn * 128 + 32 * wc + 8 * fq) = w;
                }
            }
    }
};

struct EpiDown {
    float* out; const LAS int* tab; const int* ltok; const float* lw;
    DI void operator()(const Acc& acc, const Unit& u, int wr, int wc, int fr, int fq) const {
        const int cnt = tab[u.g];
#pragma unroll
        for (int ai = 0; ai < 2; ++ai)
#pragma unroll
            for (int m = 0; m < 4; ++m) {
                const int lr = ai * 128 + wr * 64 + m * 16 + fr, rank = u.aux * 256 + lr;
                if (rank < cnt) {
                    const int tok = ltok[(size_t)u.g * LCAP + rank]; const float w = lw[(size_t)u.g * LCAP + rank];
#pragma unroll
                    for (int bj = 0; bj < 2; ++bj) {
                        float* p = out + (size_t)tok * 1024 + u.pn * 256 + 64 * wc + 32 * bj + 8 * fq;
                        const f32x4 o0 = *(const f32x4*)p + acc[ai][bj][m][0] * w, o1 = *(const f32x4*)(p + 4) + acc[ai][bj][m][1] * w;
                        *(f32x4*)p = o0; *(f32x4*)(p + 4) = o1;
                    }
                }
            }
    }
};

struct Args {
    const float *x, *norm_mix_g, *w_in, *ret_gn_g, *w_ret_o, *q_norm_g, *k_norm_g, *sinks, *w_swa_o, *w_out, *norm_ffn_g, *w_rg, *b_rg, *w_re, *b_re, *w_gate, *w_up, *w_down;
    float* out; unsigned char* ws;
};

DI void transpose_item(const float* colp, int ldn, bf16_t* WT, int K, int p0, int k0, LAS float* scr, int lane) {
#pragma unroll 8
    for (int i = 0; i < 32; ++i) { const int kk = 2 * i + (lane >> 5); scr[kk * 33 + (lane & 31)] = colp ? colp[(size_t)(k0 + kk) * ldn] : 0.f; }
    asm volatile("s_waitcnt lgkmcnt(0)" ::: "memory");
    const int c = lane & 7;
#pragma unroll
    for (int j = 0; j < 4; ++j) { const int n = (lane >> 3) + 8 * j; const LAS float* s = scr + (8 * c) * 33 + n;
        u32x4 o; o.x = pk2(s[0 * 33], s[1 * 33]); o.y = pk2(s[2 * 33], s[3 * 33]); o.z = pk2(s[4 * 33], s[5 * 33]); o.w = pk2(s[6 * 33], s[7 * 33]);
        *(u32x4*)(WT + (size_t)(p0 + n) * K + k0 + 8 * c) = o; }
    asm volatile("s_waitcnt lgkmcnt(0)" ::: "memory");
}
DI void sincos_d(double a, double& s, double& c) {
    const double q = __builtin_rint(a * 0.63661977236758134308);
    const double r = (a - q * 1.57079632679489655800) - q * 6.12323399573676603587e-17;
    const double r2 = r * r;
    double sp = r * (1.0 + r2 * (-1.0 / 6 + r2 * (1.0 / 120 + r2 * (-1.0 / 5040 + r2 * (1.0 / 362880 + r2 * (-1.0 / 39916800 + r2 * (1.0 / 6227020800.0)))))));
    double cp = 1.0 + r2 * (-0.5 + r2 * (1.0 / 24 + r2 * (-1.0 / 720 + r2 * (1.0 / 40320 + r2 * (-1.0 / 3628800 + r2 * (1.0 / 479001600.0 + r2 * (-1.0 / 87178291200.0)))))));
    const int qi = ((int)q) & 3;
    s = (qi == 0) ? sp : (qi == 1) ? cp : (qi == 2) ? -sp : -cp;
    c = (qi == 0) ? cp : (qi == 1) ? -sp : (qi == 2) ? -cp : sp;
}

#define WS_PTRS \
    unsigned char* ws = A.ws; asm volatile("" : "+s"(ws)); \
    int* cnt = (int*)(ws + WS_CTL); \
    bf16_t* WinT = (bf16_t*)(ws + WS_WIN); bf16_t* WretoT = (bf16_t*)(ws + WS_WRETO); bf16_t* WswaoT = (bf16_t*)(ws + WS_WSWAO); bf16_t* WoutT = (bf16_t*)(ws + WS_WOUT); bf16_t* WrT = (bf16_t*)(ws + WS_WR); \
    float* rcos = (float*)(ws + WS_ROT); float* rsin = rcos + SEQ * 64; \
    float* SS = (float*)(ws + WS_SS); float* RT = (float*)(ws + WS_RT); \
    bf16_t* H = (bf16_t*)(ws + WS_H); bf16_t* DR = H; bf16_t* RG = H; \
    bf16_t* Qr = (bf16_t*)(ws + WS_QR); bf16_t* Kr = (bf16_t*)(ws + WS_KR); bf16_t* T = Qr; bf16_t* Wgu = Qr; \
    bf16_t* KdT = (bf16_t*)(ws + WS_KDT); bf16_t* WdT = KdT; \
    bf16_t* VT = (bf16_t*)(ws + WS_VT); bf16_t* MG = VT; \
    bf16_t* Gs = (bf16_t*)(ws + WS_GS); bf16_t* XG2 = Gs; \
    bf16_t* SQ = (bf16_t*)(ws + WS_SQ); float* LOG = (float*)(ws + WS_SQ); \
    bf16_t* SK = (bf16_t*)(ws + WS_SK); bf16_t* SVT = (bf16_t*)(ws + WS_SVT); \
    bf16_t* RP = (bf16_t*)(ws + WS_RP); bf16_t* HM = RP; \
    bf16_t* SWo = (bf16_t*)(ws + WS_SW); \
    int* LTOK = (int*)(ws + WS_LTOK); float* LW = (float*)(ws + WS_LW); \
    bf16_t* GA = (bf16_t*)A.out; bf16_t* GB = GA + (size_t)NTOK * 1024;

__global__ void __launch_bounds__(512, 2) hyb_fwd(Args A) {
    extern __shared__ __attribute__((aligned(16))) unsigned char lds_raw[];
    LAS unsigned char* lds = (LAS unsigned char*)lds_raw;
    cg::grid_group grid = cg::this_grid();
    const int tid = threadIdx.x, lane = tid & 63, wave = __builtin_amdgcn_readfirstlane(tid >> 6);
    const int G = gridDim.x, bx = blockIdx.x;
    const int gw = bx * 8 + wave, NGW = G * 8;
    const int r32 = lane & 31, hi = lane >> 5;
    LAS int* tab = (LAS int*)(lds + LDS_TAB);

    if constexpr ((PHMASK >> 0) & 1) {
        WS_PTRS;
        LAS float* scr = (LAS float*)(lds + wave * 16384);
        constexpr int I0 = 16 * 184, I1 = 16 * 32, I2 = 8 * 32, I3 = 16 * 32, I4 = 16 * 8, NI = I0 + I1 + I2 + I3 + I4;
        for (int it = gw; it < NI; it += NGW) {
            int r = it;
            if (r < I0) { const int kb = r / 184, pb = r % 184, p = pb * 32 + (lane & 31), tile = p >> 8;
                const int src = tile * 256 + (tile < 4 ? colmap_rot(p & 255) : colmap_std(p & 255));
                transpose_item(A.w_in + src, INW, WinT, 1024, pb * 32, kb * 64, scr, lane); continue; } r -= I0;
            if (r < I1) { const int kb = r / 32, pb = r % 32, p = pb * 32 + (lane & 31); const int src = (p & ~255) + colmap_std(p & 255);
                transpose_item(A.w_ret_o + src, 1024, WretoT, 1024, pb * 32, kb * 64, scr, lane); continue; } r -= I1;
            if (r < I2) { const int kb = r / 32, pb = r % 32, p = pb * 32 + (lane & 31); const int src = (p & ~255) + colmap_std(p & 255);
                transpose_item(A.w_swa_o + src, 1024, WswaoT, 512, pb * 32, kb * 64, scr, lane); continue; } r -= I2;
            if (r < I3) { const int kb = r / 32, pb = r % 32, p = pb * 32 + (lane & 31); const int src = (p & ~255) + colmap_std(p & 255);
                transpose_item(A.w_out + src, 1024, WoutT, 1024, pb * 32, kb * 64, scr, lane); continue; } r -= I3;
            { const int kb = r / 8, pb = r % 8, p = pb * 32 + (lane & 31); const int L = colmap_std(p);
                const float* cp = L < 4 ? A.w_rg + L : (L < 36 ? A.w_re + (L - 4) : nullptr); const int ldn = L < 4 ? 4 : 32;
                transpose_item(cp, ldn, WrT, 1024, pb * 32, kb * 64, scr, lane); }
        }
        for (int m = gw; m < NTOK; m += NGW) {
            const f32x4* xr = (const f32x4*)(A.x + (size_t)m * DM) + lane;
            f32x4 v[4]; float s = 0.f;
#pragma unroll
            for (int j = 0; j < 4; ++j) { v[j] = xr[64 * j]; s += (v[j][0] * v[j][0] + v[j][1] * v[j][1]) + (v[j][2] * v[j][2] + v[j][3] * v[j][3]); }
            const float r = 1.0f / sqrtf(wave_sum(s) * (1.0f / DM) + EPS);
            u32x2* o8 = (u32x2*)(H + (size_t)m * DM) + lane;
#pragma unroll
            for (int j = 0; j < 4; ++j) { const f32x4 g = ((const f32x4*)A.norm_mix_g)[lane + 64 * j]; const f32x4 y = v[j] * r * g; u32x2 w; w.x = pk2(y[0], y[1]); w.y = pk2(y[2], y[3]); o8[64 * j] = w; }
        }
        for (int e = bx * 512 + tid; e < SEQ * 64; e += G * 512) {
            const int pos = e >> 6, i = e & 63;
            double inv = 1.0; for (int k = 0; k < i; ++k) inv *= 0.8659643233600653;
            double s, c; sincos_d((double)pos * inv, s, c);
            rcos[e] = (float)c; rsin[e] = (float)s;
        }
    }
    grid.sync();

    if constexpr ((PHMASK >> 1) & 1) {
        WS_PTRS;
        pg8::DenseOrder S; S.init(NTOK, INW, 1024, G, bx, WinT);
        EpiProj E{Qr, Kr, KdT, VT, Gs, SQ, SK, SVT, GA, GB, rcos, rsin, A.q_norm_g, A.k_norm_g};
        pg8::gemm_phase(lds, (const char*)H, 1024, S, E);
    }
    grid.sync();

    if constexpr ((PHMASK >> 2) & 1) {
        WS_PTRS;
        for (int item = bx; item < 1024; item += G) {
            const int bh = item >> 6, c = item & 63;
            const bf16_t* vt = VT + ((size_t)(bh * 256 + 32 * wave + r32)) * SEQ + c * 128 + 8 * hi;
            const bf16_t* kt = KdT + ((size_t)(bh * 128 + r32)) * SEQ + c * 128 + 8 * hi;
            f32x16 acc[4];
#pragma unroll
            for (int d = 0; d < 4; ++d)
#pragma unroll
                for (int r = 0; r < 16; ++r) acc[d][r] = 0.f;
#pragma unroll
            for (int s = 0; s < 8; ++s) {
                const bf16x8 a = *(const bf16x8*)(vt + 16 * s);
#pragma unroll
                for (int d = 0; d < 4; ++d) { const bf16x8 b = *(const bf16x8*)(kt + (size_t)d * 32 * SEQ + 16 * s); acc[d] = MFMA32(a, b, acc[d]); }
            }
            bf16_t* dr = DR + (size_t)item * 32768;
#pragma unroll
            for (int d = 0; d < 4; ++d)
#pragma unroll
                for (int r = 0; r < 16; ++r) dr[(32 * wave + crow(r, hi)) * 128 + d * 32 + r32] = f2bf(acc[d][r]);
        }
        for (int wi = gw; wi < 8192; wi += NGW) {
            const int ib = wi & 3, g = (wi >> 2) & 3, n = (wi >> 4) & 63, kvh = (wi >> 10) & 1, b = wi >> 11;
            const int head = kvh * 4 + g;
            const int tokq = b * SEQ + n * 128 + ib * 32 + r32;
            bf16x8 qf[4];
#pragma unroll
            for (int s = 0; s < 4; ++s) qf[s] = *(const bf16x8*)(SQ + (size_t)tokq * 512 + head * 64 + 16 * s + 8 * hi);
            f32x16 X[5];
            float mx = A.sinks[head];
            const float sink = mx;
#pragma unroll
            for (int kb = 0; kb < 5; ++kb) {
                const int kp0 = n * 128 - 128 + 32 * (ib + kb);
#pragma unroll
                for (int r = 0; r < 16; ++r) X[kb][r] = 0.f;
                if (kp0 >= 0) {
                    const bf16_t* kp = SK + (size_t)(b * SEQ + kp0 + r32) * 128 + kvh * 64 + 8 * hi;
#pragma unroll
                    for (int s = 0; s < 4; ++s) { const bf16x8 a = *(const bf16x8*)(kp + 16 * s); X[kb] = MFMA32(a, qf[s], X[kb]); }
                }
#pragma unroll
                for (int r = 0; r < 16; ++r) {
                    const int j = crow(r, hi);
                    const bool valid = (kp0 >= 0) && (kb == 0 ? (j > r32) : (kb == 4 ? (j <= r32) : true));
                    X[kb][r] = valid ? X[kb][r] : -INFINITY;
                    mx = fmaxf(mx, X[kb][r]);
                }
            }
            mx = fmaxf(mx, __shfl_xor(mx, 32));
            float den = 0.f;
#pragma unroll
            for (int kb = 0; kb < 5; ++kb)
#pragma unroll
                for (int r = 0; r < 16; ++r) { const float p = __expf(X[kb][r] - mx); X[kb][r] = p; den += p; }
            den += __shfl_xor(den, 32);
            den += __expf(sink - mx);
            const float rden = 1.0f / den;
            f32x16 o[2];
#pragma unroll
            for (int d = 0; d < 2; ++d)
#pragma unroll
                for (int r = 0; r < 16; ++r) o[d][r] = 0.f;
#pragma unroll
            for (int kb = 0; kb < 5; ++kb) {
                const int kp0 = n * 128 - 128 + 32 * (ib + kb);
                if (kp0 >= 0) {
#pragma unroll
                    for (int s2 = 0; s2 < 2; ++s2) {
                        const bf16x8 pb = pack8(X[kb], s2);
#pragma unroll
                        for (int d = 0; d < 2; ++d) {
                            const bf16_t* vp = SVT + ((size_t)((b * 2 + kvh) * 64 + d * 32 + r32)) * SEQ + kp0 + 16 * s2 + 4 * hi;
                            const u32x2 lo = *(const u32x2*)vp, hh = *(const u32x2*)(vp + 8);
                            u32x4 av; av.x = lo.x; av.y = lo.y; av.z = hh.x; av.w = hh.y;
                            o[d] = MFMA32(__builtin_bit_cast(bf16x8, av), pb, o[d]);
                        }
                    }
                }
            }
#pragma unroll
            for (int d = 0; d < 2; ++d)
#pragma unroll
                for (int q = 0; q < 4; ++q) {
                    u32x2 w; w.x = pk2(o[d][4 * q] * rden, o[d][4 * q + 1] * rden); w.y = pk2(o[d][4 * q + 2] * rden, o[d][4 * q + 3] * rden);
                    *(u32x2*)(SWo + (size_t)tokq * 512 + head * 64 + d * 32 + 8 * q + 4 * hi) = w;
                }
        }
    }
    grid.sync();

    if constexpr ((PHMASK >> 3) & 1) {
        WS_PTRS;
        for (int gi = bx * 512 + tid; gi < 16 * 8192; gi += G * 512) {
            const int bh = gi >> 13, e4 = gi & 8191, h = bh & 3;
            const float dec = __builtin_amdgcn_exp2f(128.0f * lg2gamma(h));
            float r0 = 0.f, r1 = 0.f, r2 = 0.f, r3 = 0.f;
            const size_t base = (size_t)bh * 64 * 32768 + (size_t)e4 * 4;
#pragma unroll 4
            for (int c = 0; c < 64; ++c) {
                const u32x2 d = *(const u32x2*)(DR + base + (size_t)c * 32768);
                u32x2 w; w.x = pk2(r0, r1); w.y = pk2(r2, r3);
                *(u32x2*)(RP + base + (size_t)c * 32768) = w;
                r0 = r0 * dec + bflo(d.x); r1 = r1 * dec + bfhi(d.x); r2 = r2 * dec + bflo(d.y); r3 = r3 * dec + bfhi(d.y);
            }
        }
    }
    grid.sync();

    if constexpr ((PHMASK >> 4) & 1) {
        WS_PTRS;
        LAS float* xs = (LAS float*)lds;
        for (int item = bx; item < 1024; item += G) {
            const int bh = item >> 6, c = item & 63, b = bh >> 2, h = bh & 3, ib = wave & 3, dh = wave >> 2;
            const int tok0 = b * SEQ + c * 128;
            const int tok = tok0 + ib * 32 + r32;
            const float lg = lg2gamma(h);
            bf16x8 qf[8];
#pragma unroll
            for (int s = 0; s < 8; ++s) qf[s] = *(const bf16x8*)(Qr + (size_t)tok * 512 + h * 128 + 16 * s + 8 * hi);
            f32x16 acc[4];
#pragma unroll
            for (int d = 0; d < 4; ++d)
#pragma unroll
                for (int r = 0; r < 16; ++r) acc[d][r] = 0.f;
            const bf16_t* rp = RP + (size_t)item * 32768 + (size_t)(dh * 128 + r32) * 128 + 8 * hi;
#pragma unroll
            for (int d = 0; d < 4; ++d)
#pragma unroll
                for (int s = 0; s < 8; ++s) { const bf16x8 a = *(const bf16x8*)(rp + d * 32 * 128 + 16 * s); acc[d] = MFMA32(a, qf[s], acc[d]); }
            const int il = ib * 32 + r32;
            const float fc = __builtin_amdgcn_exp2f((float)(il + 1) * lg);
#pragma unroll
            for (int d = 0; d < 4; ++d)
#pragma unroll
                for (int r = 0; r < 16; ++r) acc[d][r] *= fc;
            for (int jb = 0; jb <= ib; ++jb) {
                f32x16 X;
#pragma unroll
                for (int r = 0; r < 16; ++r) X[r] = 0.f;
                const bf16_t* kp = Kr + (size_t)(tok0 + jb * 32 + r32) * 512 + h * 128 + 8 * hi;
#pragma unroll
                for (int s = 0; s < 8; ++s) { const bf16x8 a = *(const bf16x8*)(kp + 16 * s); X = MFMA32(a, qf[s], X); }
#pragma unroll
                for (int r = 0; r < 16; ++r) { const int dd = il - (jb * 32 + crow(r, hi)); X[r] = dd >= 0 ? X[r] * __builtin_amdgcn_exp2f((float)dd * lg) : 0.f; }
#pragma unroll
                for (int s2 = 0; s2 < 2; ++s2) {
                    const bf16x8 pb = pack8(X, s2);
#pragma unroll
                    for (int d = 0; d < 4; ++d) {
                        const bf16_t* vp = VT + ((size_t)(bh * 256 + dh * 128 + d * 32 + r32)) * SEQ + c * 128 + jb * 32 + 16 * s2 + 4 * hi;
                        const u32x2 lo = *(const u32x2*)vp, hh = *(const u32x2*)(vp + 8);
                        u32x4 av; av.x = lo.x; av.y = lo.y; av.z = hh.x; av.w = hh.y;
                        acc[d] = MFMA32(__builtin_bit_cast(bf16x8, av), pb, acc[d]);
                    }
                }
            }
            float sm = 0.f, sq = 0.f;
#pragma unroll
            for (int d = 0; d < 4; ++d)
#pragma unroll
                for (int r = 0; r < 16; ++r) { sm += acc[d][r]; sq += acc[d][r] * acc[d][r]; }
            sm += __shfl_xor(sm, 32); sq += __shfl_xor(sq, 32);
            if (hi == 0) { xs[((dh * 4 + ib) * 32 + r32) * 2] = sm; xs[((dh * 4 + ib) * 32 + r32) * 2 + 1] = sq; }
            __syncthreads();
            sm += xs[(((dh ^ 1) * 4 + ib) * 32 + r32) * 2]; sq += xs[(((dh ^ 1) * 4 + ib) * 32 + r32) * 2 + 1];
            __syncthreads();
            const float mu = sm * (1.0f / 256.0f);
            const float var = fmaxf(sq * (1.0f / 256.0f) - mu * mu, 0.f);
            const float rstd = 1.0f / sqrtf(var + EPS);
#pragma unroll
            for (int d = 0; d < 4; ++d)
#pragma unroll
                for (int q = 0; q < 4; ++q) {
                    const int dv = dh * 128 + d * 32 + 8 * q + 4 * hi;
                    const f32x4 gn = *(const f32x4*)(A.ret_gn_g + h * 256 + dv);
                    const u32x2 gs = *(const u32x2*)(Gs + (size_t)tok * 1024 + h * 256 + dv);
                    const float y0 = (acc[d][4 * q] - mu) * rstd * gn[0] * bflo(gs.x), y1 = (acc[d][4 * q + 1] - mu) * rstd * gn[1] * bfhi(gs.x);
                    const float y2 = (acc[d][4 * q + 2] - mu) * rstd * gn[2] * bflo(gs.y), y3 = (acc[d][4 * q + 3] - mu) * rstd * gn[3] * bfhi(gs.y);
                    u32x2 w; w.x = pk2(y0, y1); w.y = pk2(y2, y3);
                    *(u32x2*)(RG + (size_t)tok * 1024 + h * 256 + dv) = w;
                }
        }
    }
    grid.sync();

    if constexpr ((PHMASK >> 5) & 1) {
        WS_PTRS;
        { pg8::DenseOrder S; S.init(NTOK, 1024, 1024, G, bx, WretoT); EpiMerge<0> E{GA, T, MG}; pg8::gemm_phase(lds, (const char*)RG, 1024, S, E); }
        { pg8::DenseOrder S; S.init(NTOK, 1024, 512, G, bx, WswaoT); EpiMerge<1> E{GB, T, MG}; pg8::gemm_phase(lds, (const char*)SWo, 512, S, E); }
    }
    grid.sync();

    if constexpr ((PHMASK >> 6) & 1) {
        WS_PTRS;
        pg8::DenseOrder S; S.init(NTOK, 1024, 1024, G, bx, WoutT);
        EpiOut E{A.x, A.out, XG2, SS, A.norm_ffn_g};
        pg8::gemm_phase(lds, (const char*)MG, 1024, S, E);
    }
    grid.sync();

    if constexpr ((PHMASK >> 7) & 1) {
        WS_PTRS;
        LAS float* scr = (LAS float*)(lds + wave * 16384);
        constexpr int IU = 32 * 16 * 32, ID = 32 * 8 * 32;
        for (int it = gw; it < IU + ID; it += NGW) {
            if (it < IU) { const int e = it >> 9, r = it & 511, kb = r >> 5, pb = r & 31, p = pb * 32 + (lane & 31);
                const int pl = p & 255, bj = pl >> 7, wc = (pl >> 5) & 3, n = (pl >> 4) & 1, fq = (pl >> 2) & 3, j = pl & 3;
                const int ffc = 128 * (p >> 8) + 32 * wc + 8 * fq + 4 * n + j;
                const float* src = (bj == 0 ? A.w_gate : A.w_up) + (size_t)e * 1024 * 512 + ffc;
                transpose_item(src, 512, Wgu + (size_t)e * 1024 * 1024, 1024, pb * 32, kb * 64, scr, lane);
            } else { const int r0 = it - IU, e = r0 >> 8, r = r0 & 255, kb = r >> 5, pb = r & 31, p = pb * 32 + (lane & 31);
                const int src = (p & ~255) + colmap_std(p & 255);
                transpose_item(A.w_down + (size_t)e * 512 * 1024 + src, 1024, WdT + (size_t)e * 1024 * 512, 512, pb * 32, kb * 64, scr, lane);
            }
        }
        __syncthreads();
        pg8::DenseOrder S; S.init(NTOK, 256, 1024, G, bx, WrT);
        EpiRouter E{LOG};
        pg8::gemm_phase(lds, (const char*)XG2, 1024, S, E);
    }
    grid.sync();

    if constexpr ((PHMASK >> 8) & 1) {
        WS_PTRS;
        for (int t = bx * 512 + tid; t < NTOK; t += G * 512) {
            float ss = 0.f;
#pragma unroll
            for (int k = 0; k < 4; ++k) { const f32x4 v = *(const f32x4*)(SS + (size_t)t * 16 + 4 * k); ss += (v[0] + v[1]) + (v[2] + v[3]); }
            const float r = 1.0f / sqrtf(ss * (1.0f / DM) + EPS);
            RT[t] = r;
            const f32x4 lg4 = *(const f32x4*)(LOG + (size_t)t * 64);
            float gl[4];
#pragma unroll
            for (int k = 0; k < 4; ++k) gl[k] = lg4[k] * r + A.b_rg[k];
            int gi = 0; float gm = gl[0];
#pragma unroll
            for (int k = 1; k < 4; ++k) if (gl[k] > gm) { gm = gl[k]; gi = k; }
            float gs = 0.f;
#pragma unroll
            for (int k = 0; k < 4; ++k) gs += __expf(gl[k] - gm);
            const float gprob = 1.0f / gs;
            float el[8];
            { const f32x4 a = *(const f32x4*)(LOG + (size_t)t * 64 + 4 + gi * 8), b2 = *(const f32x4*)(LOG + (size_t)t * 64 + 8 + gi * 8);
#pragma unroll
              for (int k = 0; k < 4; ++k) { el[k] = a[k] * r + A.b_re[gi * 8 + k]; el[4 + k] = b2[k] * r + A.b_re[gi * 8 + 4 + k]; } }
            int e0 = 0; float m0 = el[0];
#pragma unroll
            for (int k = 1; k < 8; ++k) if (el[k] > m0) { m0 = el[k]; e0 = k; }
            int e1 = -1; float m1 = -INFINITY;
#pragma unroll
            for (int k = 0; k < 8; ++k) if (k != e0 && el[k] > m1) { m1 = el[k]; e1 = k; }
            const float x1 = __expf(m1 - m0);
            const float w0 = gprob / (1.0f + x1), w1 = gprob * x1 / (1.0f + x1);
            const int ga = gi * 8 + e0, gb = 32 + gi * 8 + e1;
            const int ra = atomicAdd(cnt + ga, 1); LTOK[(size_t)ga * LCAP + ra] = t; LW[(size_t)ga * LCAP + ra] = w0;
            const int rb = atomicAdd(cnt + gb, 1); LTOK[(size_t)gb * LCAP + rb] = t; LW[(size_t)gb * LCAP + rb] = w1;
        }
    }
    grid.sync();

    if (tid == 0) {
        WS_PTRS;
        int tp = 0;
        for (int g = 0; g < 64; ++g) { const int c = cnt[g]; tab[g] = c; tab[64 + g] = tp; tab[192 + g] = tp * 256; tp += (c + 255) >> 8; }
        tab[128] = tp;
    }
    __syncthreads();

    if constexpr ((PHMASK >> 9) & 1) {
        WS_PTRS;
        pg8::GroupOrder S; S.init(tab, 0, 64, 1024, G, bx, Wgu, (size_t)1024 * 1024 * 2, LTOK, true);
        EpiUp E{HM, tab, LTOK, RT};
        pg8::gemm_phase(lds, (const char*)XG2, 1024, S, E);
    }
    grid.sync();
    if constexpr ((PHMASK >> 10) & 1) {
        WS_PTRS;
        pg8::GroupOrder S; S.init(tab, 0, 32, 512, G, bx, WdT, (size_t)1024 * 512 * 2, LTOK, false);
        EpiDown E{A.out, tab, LTOK, LW};
        pg8::gemm_phase(lds, (const char*)HM, 512, S, E);
    }
    grid.sync();
    if constexpr ((PHMASK >> 11) & 1) {
        WS_PTRS;
        pg8::GroupOrder S; S.init(tab, 32, 32, 512, G, bx, WdT, (size_t)1024 * 512 * 2, LTOK, false);
        EpiDown E{A.out, tab, LTOK, LW};
        pg8::gemm_phase(lds, (const char*)HM, 512, S, E);
    }
}

extern "C" void kernel_launch(void* const* d_in, const int* in_sizes, int n_in, void* d_out, int out_size, void* d_ws, size_t ws_size, hipStream_t stream) {
    static int grid = 0;
    if (grid == 0) {
        if (n_in != 18 || out_size != NTOK * DM || ws_size < WS_END) { fprintf(stderr, "kernel_launch: unexpected shapes (n_in %d out %d ws %zu)\n", n_in, out_size, ws_size); grid = -1; return; }
        int dev = 0, cus = 0, per_cu = 0;
        hipGetDevice(&dev);
        hipDeviceGetAttribute(&cus, hipDeviceAttributeMultiprocessorCount, dev);
        hipFuncSetAttribute((const void*)hyb_fwd, hipFuncAttributeMaxDynamicSharedMemorySize, LDS_BYTES);
        hipOccupancyMaxActiveBlocksPerMultiprocessor(&per_cu, (const void*)hyb_fwd, 512, LDS_BYTES);
        (void)hipGetLastError();
        if (per_cu < 1) { fprintf(stderr, "kernel_launch: occupancy query says %d blocks per CU\n", per_cu); per_cu = 1; }
        grid = cus;
    }
    if (grid < 0) return;
    hipMemsetAsync((char*)d_ws + WS_CTL, 0, 4096, stream);
    Args a{};
    a.x = (const float*)d_in[0]; a.norm_mix_g = (const float*)d_in[1]; a.w_in = (const float*)d_in[2]; a.ret_gn_g = (const float*)d_in[3]; a.w_ret_o = (const float*)d_in[4];
    a.q_norm_g = (const float*)d_in[5]; a.k_norm_g = (const float*)d_in[6]; a.sinks = (const float*)d_in[7]; a.w_swa_o = (const float*)d_in[8]; a.w_out = (const float*)d_in[9];
    a.norm_ffn_g = (const float*)d_in[10]; a.w_rg = (const float*)d_in[11]; a.b_rg = (const float*)d_in[12]; a.w_re = (const float*)d_in[13]; a.b_re = (const float*)d_in[14];
    a.w_gate = (const float*)d_in[15]; a.w_up = (const float*)d_in[16]; a.w_down = (const float*)d_in[17];
    a.out = (float*)d_out; a.ws = (unsigned char*)d_ws;
    void* args[] = {&a};
    hipError_t e = hipLaunchCooperativeKernel((const void*)hyb_fwd, dim3(grid), dim3(512), args, LDS_BYTES, stream);
    if (e != hipSuccess) fprintf(stderr, "cooperative launch failed: %s (grid %d)\n", hipGetErrorString(e), grid);
}
```

```cpp
#include <hip/hip_runtime.h>
#include <hip/hip_cooperative_groups.h>
#include <cstdio>
#include <cstdint>
namespace cg = cooperative_groups;
#ifndef PHMASK
#define PHMASK 0xFFFF
#endif
#ifndef WGM_P1
#define WGM_P1 2
#endif
#ifndef WGM_P5
#define WGM_P5 8
#endif
#ifndef WGM_P6
#define WGM_P6 8
#endif
#ifndef ABL
#define ABL 0
#endif
#ifndef PROBE_A
#define PROBE_A -1
#endif
#ifndef PROBE_BASE
#define PROBE_BASE 0
#endif
#ifndef PROBE_B
#define PROBE_B -1
#endif

#define LAS __attribute__((address_space(3)))
typedef unsigned short bf16_t;
typedef short bf16x8 __attribute__((ext_vector_type(8)));
typedef float f32x4 __attribute__((ext_vector_type(4)));
typedef float f32x16 __attribute__((ext_vector_type(16)));
typedef unsigned u32x4 __attribute__((ext_vector_type(4)));
typedef int i32x4 __attribute__((ext_vector_type(4)));
typedef float f32x2 __attribute__((ext_vector_type(2)));
typedef unsigned u32x2 __attribute__((ext_vector_type(2)));
typedef float f32x2_t __attribute__((ext_vector_type(2)));
typedef __bf16 bf16x2_t __attribute__((ext_vector_type(2)));

constexpr int DM = 1024, SEQ = 8192, NTOK = 32768, INW = 5888;
constexpr int NE = 32, DFF = 512;
constexpr float EPS = 1e-6f;
constexpr int LCAP = 32768;

constexpr size_t MiB = 1u << 20;
constexpr size_t WS_CTL = 0;
constexpr size_t WS_WIN = 1 * MiB;
constexpr size_t WS_WRETO = 13 * MiB;
constexpr size_t WS_WSWAO = 15 * MiB;
constexpr size_t WS_WOUT = 16 * MiB;
constexpr size_t WS_WR = 18 * MiB;
constexpr size_t WS_ROT = 19 * MiB;
constexpr size_t WS_SS = 23 * MiB;
constexpr size_t WS_RT = 25 * MiB;
constexpr size_t WS_WGU = 26 * MiB;
constexpr size_t WS_WDT = 90 * MiB;
constexpr size_t WS_H = 122 * MiB;
constexpr size_t WS_QR = 186 * MiB;
constexpr size_t WS_KR = 218 * MiB;
constexpr size_t WS_VT = 250 * MiB;
constexpr size_t WS_GS = 314 * MiB;
constexpr size_t WS_KDT = 378 * MiB;
constexpr size_t WS_SQ = 410 * MiB;
constexpr size_t WS_SK = 442 * MiB;
constexpr size_t WS_SVT = 450 * MiB;
constexpr size_t WS_SW = 458 * MiB;
constexpr size_t WS_LTOK = 490 * MiB;
constexpr size_t WS_LW = 498 * MiB;
constexpr size_t WS_END = 506 * MiB;

constexpr int LDS_BYTES = 147456;
constexpr int LDS_TAB = 131072;

#define DI __device__ __forceinline__
DI unsigned pk2(float lo, float hi) { f32x2_t v = {lo, hi}; bf16x2_t b = __builtin_convertvector(v, bf16x2_t); return __builtin_bit_cast(unsigned, b); }
DI float bflo(unsigned w) { return __uint_as_float(w << 16); }
DI float bfhi(unsigned w) { return __uint_as_float(w & 0xffff0000u); }
DI bf16_t f2bf(float f) { return (bf16_t)(pk2(f, 0.f) & 0xffffu); }
DI float wave_max(float v) {
#pragma unroll
    for (int o = 1; o < 64; o <<= 1) v = fmaxf(v, __shfl_xor(v, o));
    return v;
}
DI float wave_sum(float v) {
#pragma unroll
    for (int o = 1; o < 64; o <<= 1) v += __shfl_xor(v, o);
    return v;
}
DI float sigmoidf_(float v) { return __builtin_amdgcn_rcpf(1.0f + __expf(-v)); }
DI float siluf_(float v) { return v * __builtin_amdgcn_rcpf(1.0f + __expf(-v)); }
#define MFMA32(a, b, c) __builtin_amdgcn_mfma_f32_32x32x16_bf16((a), (b), (c), 0, 0, 0)
DI int crow(int reg, int h) { return (reg & 3) + 8 * (reg >> 2) + 4 * h; }
DI bf16x8 pack8(const f32x16& x, int s) {
    u32x4 p; p.x = pk2(x[8 * s], x[8 * s + 1]); p.y = pk2(x[8 * s + 2], x[8 * s + 3]); p.z = pk2(x[8 * s + 4], x[8 * s + 5]); p.w = pk2(x[8 * s + 6], x[8 * s + 7]);
    return __builtin_bit_cast(bf16x8, p);
}
DI float lg2gamma(int h) { return h == 0 ? -0.04580368961312479f : h == 1 ? -0.02272007650008353f : h == 2 ? -0.011315313227834146f : -0.005646563141142063f; }

DI int colmap_std(int p) { const int bj = p >> 7, wc = (p >> 5) & 3, n = (p >> 4) & 1, fq = (p >> 2) & 3, j = p & 3; return 64 * wc + 32 * bj + 8 * fq + 4 * n + j; }
DI int colmap_gate(int p) { const int bj = p >> 7, wc = (p >> 5) & 3, n = (p >> 4) & 1, fq = (p >> 2) & 3, j = p & 3; return 64 * wc + 16 * fq + 8 * bj + 4 * n + j; }
DI int colmap_rot(int p) { const int bj = p >> 7, wc = (p >> 5) & 3, n = (p >> 4) & 1, fq = (p >> 2) & 3, j = p & 3; return 128 * bj + 64 * n + 16 * wc + 4 * fq + j; }

namespace pg8 {
constexpr int BM = 256, BK = 64, HALF = 128, HTB = HALF * BK * 2, STAGE_BYTES = 8 * HTB, NXCD = 8, WGM = 8;
DI int lds_byte(int r, int c) { const int st = (r >> 4) * 2 + (c >> 5), rr = r & 15, cc = c & 31, ob = rr * 64 + cc * 2; return st * 1024 + (ob ^ (((ob >> 9) & 1) << 5)); }
DI void stage_rc(int b, int& R, int& C) { const int st = b / 1024, sb = b % 1024, swz = sb ^ (((sb >> 9) & 1) << 5); R = (st >> 1) * 16 + swz / 64; C = (st & 1) * 32 + (swz % 64) / 2; }

struct Unit { int pm, pn, g, aux, half; };

template <class Epi, class Sched, int T1 = 0, bool I8 = false, int KT = 0>
DI void gemm_phase(LAS unsigned char* lds, const char* Abase, const int K, const Sched& S, const Epi& E, const char* A2 = nullptr) {
    int tid_ = threadIdx.x; asm volatile("" : "+v"(tid_));
    const int tid = tid_, wid = __builtin_amdgcn_readfirstlane(tid >> 6), lane = tid & 63, wr = wid >> 2, wc = wid & 3, fr = lane & 15, fq = lane >> 4;
    const int nt = KT > 0 ? KT : K / BK;
    int Rr[2], Cc[2]; unsigned voffB[2];
#pragma unroll
    for (int i = 0; i < 2; ++i) { stage_rc(tid * 16 + i * 8192, Rr[i], Cc[i]); voffB[i] = (unsigned)(Rr[i] * K + Cc[i]) * 2u; }
    const size_t kstep = (size_t)(BK * 2);
    const size_t hstep = (size_t)HALF * K * 2;
    const unsigned ldsw = (unsigned)wid * 1024u;
    const int aoff = lds_byte(wr * 64 + fr, fq * 8), boff = lds_byte(wc * 32 + fr, fq * 8);
#define PG8_SA(b, h) (((b) * 2 + (h)) * HTB)
#define PG8_SB(b, h) ((4 + (b) * 2 + (h)) * HTB)
#define PG8_STAGE(bufoff, gbase, voff) do { _Pragma("unroll") for (int _i = 0; _i < 2; ++_i) \
        __builtin_amdgcn_global_load_lds((const unsigned*)((const char*)(gbase) + (voff)[_i]), (LAS unsigned*)(lds + (bufoff) + ldsw + _i * 8192), 16, 0, 0); } while (0)
#define PG8_LDA(dst, b, h) do { _Pragma("unroll") for (int m = 0; m < 4; ++m) _Pragma("unroll") for (int k = 0; k < 2; ++k) dst[m][k] = *(const LAS bf16x8*)(lds + PG8_SA(b, h) + aoff + m * 2048 + k * 1024); } while (0)
#define PG8_LDB(dst, b, h) do { _Pragma("unroll") for (int n = 0; n < 2; ++n) _Pragma("unroll") for (int k = 0; k < 2; ++k) dst[n][k] = *(const LAS bf16x8*)(lds + PG8_SB(b, h) + boff + n * 2048 + k * 1024); } while (0)
#define PG8_MMA(ai, bj, At, Bt) do { __builtin_amdgcn_s_setprio(1); _Pragma("unroll") for (int m = 0; m < 4; ++m) _Pragma("unroll") for (int n = 0; n < 2; ++n) _Pragma("unroll") for (int k = 0; k < 2; ++k) \
        { if constexpr (I8) acc[ai][bj][m][n] = __builtin_bit_cast(f32x4, __builtin_amdgcn_mfma_i32_16x16x64_i8(__builtin_bit_cast(i32x4, Bt[n][k]), __builtin_bit_cast(i32x4, At[m][k]), __builtin_bit_cast(i32x4, acc[ai][bj][m][n]), 0, 0, 0)); \
          else acc[ai][bj][m][n] = __builtin_amdgcn_mfma_f32_16x16x32_bf16(Bt[n][k], At[m][k], acc[ai][bj][m][n], 0, 0, 0); } __builtin_amdgcn_s_setprio(0); } while (0)
#define PG8_WAIT_V(n) asm volatile("s_waitcnt vmcnt(" #n ")" ::: "memory")
#define PG8_WAIT_L(n) asm volatile("s_waitcnt lgkmcnt(" #n ")" ::: "memory")
#define PG8_BAR __builtin_amdgcn_s_barrier()
#define PG8_SCHED __builtin_amdgcn_sched_barrier(0)
    Unit cur, nxt; int ui = 0;
    if (!S.next(0, cur)) return;
    f32x4 acc[2][2][4][2];
#pragma unroll
    for (int a = 0; a < 2; ++a)
#pragma unroll
        for (int b = 0; b < 2; ++b)
#pragma unroll
            for (int m = 0; m < 4; ++m)
#pragma unroll
                for (int n = 0; n < 2; ++n) acc[a][b][m][n] = (f32x4){0.f, 0.f, 0.f, 0.f};
    bf16x8 At[4][2], B0[2][2], B1[2][2];
    unsigned co[2][2], no[2][2];
    S.aoffs(cur, Rr, Cc, co);
    const char* cB = S.bbase(cur);
    PG8_STAGE(PG8_SB(0, 0), cB, voffB); PG8_STAGE(PG8_SB(0, 1), cB + hstep, voffB); PG8_STAGE(PG8_SA(0, 0), Abase, co[0]); PG8_STAGE(PG8_SA(0, 1), Abase, co[1]);
    if (wr == 1) PG8_BAR;
    PG8_WAIT_V(2); PG8_BAR;
    PG8_STAGE(PG8_SB(1, 0), cB + kstep, voffB); PG8_STAGE(PG8_SA(1, 0), Abase + kstep, co[0]); PG8_STAGE(PG8_SB(1, 1), cB + hstep + kstep, voffB);
    PG8_WAIT_V(6); PG8_BAR;
    for (;;) {
        const bool has_next = S.next(ui + 1, nxt);
        const char* nB = has_next ? S.bbase(nxt) : cB;
        if (has_next) S.aoffs(nxt, Rr, Cc, no);
        else { no[0][0] = co[0][0]; no[0][1] = co[0][1]; no[1][0] = co[1][0]; no[1][1] = co[1][1]; }
        for (int t = 0; t < nt; t += 2) {
            const bool last = (t == nt - 2);
            if constexpr (I8) E.stage(lds, cur, wid, lane, ui & 1);
            if constexpr (T1 > 0) if (t == T1) { int fr_ = fr, fq_ = fq; asm volatile("" : "+v"(fr_), "+v"(fq_)); E.mid(acc, cur, wr, wc, fr_, fq_); }
            const bool sg1 = T1 > 0 && t >= T1;
            const bool sg2 = T1 > 0 && !last && t + 2 >= T1;
            const char* a1 = sg1 ? A2 + (size_t)(t + 1 - T1) * kstep : Abase + (size_t)(t + 1) * kstep;
            const char* a2 = last ? Abase : (sg2 ? A2 + (size_t)(t + 2 - T1) * kstep : Abase + (size_t)(t + 2) * kstep); const char* b2 = last ? nB : cB + (size_t)(t + 2) * kstep;
            const char* a3 = a2 + kstep; const char* b3 = b2 + kstep;
            unsigned o1[2], o2[2][2];
            o1[0] = sg1 ? (co[1][0] >> 1) + Cc[0] : co[1][0]; o1[1] = sg1 ? (co[1][1] >> 1) + Cc[1] : co[1][1];
            o2[0][0] = last ? no[0][0] : co[0][0]; o2[0][1] = last ? no[0][1] : co[0][1]; o2[1][0] = last ? no[1][0] : co[1][0]; o2[1][1] = last ? no[1][1] : co[1][1];
            if (sg2) { o2[0][0] = (o2[0][0] >> 1) + Cc[0]; o2[0][1] = (o2[0][1] >> 1) + Cc[1]; o2[1][0] = (o2[1][0] >> 1) + Cc[0]; o2[1][1] = (o2[1][1] >> 1) + Cc[1]; }
            PG8_LDB(B0, 0, 0); PG8_LDB(B1, 0, 1); PG8_SCHED; PG8_LDA(At, 0, 0); PG8_STAGE(PG8_SA(1, 1), a1, o1);
            PG8_WAIT_V(8); PG8_WAIT_L(0); PG8_BAR; if (cur.half != 2) { PG8_MMA(0, 0, At, B0); PG8_MMA(0, 1, At, B1); } PG8_BAR; PG8_SCHED;
            PG8_LDA(At, 0, 1); PG8_STAGE(PG8_SB(0, 0), b2, voffB); PG8_STAGE(PG8_SB(0, 1), b2 + hstep, voffB); PG8_STAGE(PG8_SA(0, 0), a2, o2[0]);
            PG8_WAIT_V(8); PG8_WAIT_L(0); PG8_BAR; if (cur.half != 1) { PG8_MMA(1, 0, At, B0); PG8_MMA(1, 1, At, B1); } PG8_BAR; PG8_SCHED;
            PG8_LDB(B0, 1, 0); PG8_LDB(B1, 1, 1); PG8_SCHED; PG8_LDA(At, 1, 0); PG8_STAGE(PG8_SA(0, 1), a2, o2[1]);
            PG8_WAIT_V(8); PG8_WAIT_L(0); PG8_BAR; if (cur.half != 2) { PG8_MMA(0, 0, At, B0); PG8_MMA(0, 1, At, B1); } PG8_BAR; PG8_SCHED;
            PG8_LDA(At, 1, 1); PG8_STAGE(PG8_SB(1, 0), b3, voffB); PG8_STAGE(PG8_SB(1, 1), b3 + hstep, voffB); PG8_STAGE(PG8_SA(1, 0), a3, o2[0]);
            PG8_WAIT_V(8); PG8_WAIT_L(0); PG8_BAR; if (cur.half != 1) { PG8_MMA(1, 0, At, B0); PG8_MMA(1, 1, At, B1); } PG8_BAR; PG8_SCHED;
        }
        if (wr == 0) PG8_BAR;
        { int fr_ = fr, fq_ = fq; asm volatile("" : "+v"(fr_), "+v"(fq_));
          if constexpr (I8) E.pre(acc, cur, wr, wc, fr_, fq_, (const LAS float*)(lds + 131072 + 8192 + (ui & 1) * 2048));
          E(acc, cur, wr, wc, fr_, fq_); }
        if (!has_next) break;
#pragma unroll
        for (int a = 0; a < 2; ++a)
#pragma unroll
            for (int b = 0; b < 2; ++b)
#pragma unroll
                for (int m = 0; m < 4; ++m)
#pragma unroll
                    for (int n = 0; n < 2; ++n) acc[a][b][m][n] = (f32x4){0.f, 0.f, 0.f, 0.f};
        cur = nxt; cB = nB; co[0][0] = no[0][0]; co[0][1] = no[0][1]; co[1][0] = no[1][0]; co[1][1] = no[1][1]; ++ui;
        if (wr == 1) PG8_BAR;
    }
    PG8_WAIT_V(0);
    PG8_BAR;
#undef PG8_SA
#undef PG8_SB
#undef PG8_STAGE
#undef PG8_LDA
#undef PG8_LDB
#undef PG8_MMA
#undef PG8_WAIT_V
#undef PG8_WAIT_L
#undef PG8_BAR
#undef PG8_SCHED
}

struct DenseOrder {
    int nM, nN, nwg, G, c, K, KA, wgm; const char* Bt;
    DI void init(int M, int N, int K_, int G_, int c_, const void* Bt_, int KA_ = 0, int wgm_ = WGM) { nM = M / BM; nN = N / BM; nwg = nM * nN; G = G_; c = c_; K = K_; KA = KA_ ? KA_ : K_; Bt = (const char*)Bt_; wgm = wgm_; }
    DI bool next(int i, Unit& u) const {
        const long L = (long)i * G + c; if (L >= nwg) return false;
        int wgid = (int)L; { const int q = nwg / NXCD, r = nwg % NXCD, xcd = wgid % NXCD, off = wgid / NXCD; wgid = (xcd < r ? xcd * (q + 1) : r * (q + 1) + (xcd - r) * q) + off; }
        const int nig = wgm * nN, gid = wgid / nig, fm = gid * wgm, gsz = (nM - fm) < wgm ? (nM - fm) : wgm;
        u.pm = fm + ((wgid % nig) % gsz); u.pn = (wgid % nig) / gsz; u.g = 0; u.aux = 0; u.half = 0; return true;
    }
    DI const char* bbase(const Unit& u) const { return Bt + (size_t)u.pn * BM * K * 2; }
    DI void aoffs(const Unit& u, const int (&R)[2], const int (&C)[2], unsigned (&off)[2][2]) const {
#pragma unroll
        for (int h = 0; h < 2; ++h)
#pragma unroll
            for (int i = 0; i < 2; ++i) off[h][i] = (unsigned)((u.pm * BM + h * HALF + R[i]) * KA + C[i]) * 2u;
    }
};

struct GroupOrder {
    const LAS int* tab; int g0, ng, G, c, K, nunits, nfull, nvirt; const char* Bt; size_t bstride;
    const int* ltok; bool gather;
    DI void init(const LAS int* tab_, int g0_, int ng_, int K_, int G_, int c_, const void* Bt_, size_t bstride_, const int* ltok_, bool gather_) {
        tab = tab_; g0 = g0_; ng = ng_; K = K_; G = G_; c = c_; Bt = (const char*)Bt_; bstride = bstride_; ltok = ltok_; gather = gather_;
        nunits = 4 * (tab[64 + g0 + ng] - tab[64 + g0]);
        { const int R = nunits % G; nfull = nunits - R; nvirt = (R > 0 && 2 * R <= G) ? nfull + 2 * R : nunits; if (nvirt == nunits) nfull = nunits; }
    }
    DI bool next(int i, Unit& u) const {
        const long Lv = (long)i * G + c; if (Lv >= nvirt) return false;
        const long L = Lv < nfull ? Lv : nfull + ((Lv - nfull) >> 1);
        u.half = __builtin_amdgcn_readfirstlane(Lv < nfull ? 0 : 1 + (int)((Lv - nfull) & 1));
        int wgid = (int)L; { const int nwg = nunits, q = nwg / NXCD, r = nwg % NXCD, xcd = wgid % NXCD, off = wgid / NXCD; wgid = (xcd < r ? xcd * (q + 1) : r * (q + 1) + (xcd - r) * q) + off; }
        const int T = tab[64 + g0] + (wgid >> 2);
        int g = g0;
        for (int k = g0; k < g0 + ng; ++k) if (tab[64 + k + 1] <= T) g = k + 1;
        u.g = __builtin_amdgcn_readfirstlane(g); u.aux = __builtin_amdgcn_readfirstlane(T - tab[64 + g]); u.pm = __builtin_amdgcn_readfirstlane((tab[192 + g] >> 8) + u.aux); u.pn = wgid & 3; return true;
    }
    DI const char* bbase(const Unit& u) const { return Bt + (size_t)(u.g & 31) * bstride + (size_t)u.pn * BM * K * 2; }
    DI void aoffs(const Unit& u, const int (&R)[2], const int (&C)[2], unsigned (&off)[2][2]) const {
        if (gather) {
            const int cnt = __builtin_amdgcn_readfirstlane(tab[u.g]);
#pragma unroll
            for (int h = 0; h < 2; ++h)
#pragma unroll
                for (int i = 0; i < 2; ++i) { const int rank = u.aux * BM + h * HALF + R[i]; const int tok = rank < cnt ? ltok[(size_t)u.g * LCAP + rank] : 0; off[h][i] = (unsigned)(tok * K + C[i]) * 2u; }
        } else {
#pragma unroll
            for (int h = 0; h < 2; ++h)
#pragma unroll
                for (int i = 0; i < 2; ++i) off[h][i] = (unsigned)((u.pm * BM + h * HALF + R[i]) * K + C[i]) * 2u;
        }
    }
};
}
using pg8::Unit;

#define EPI_ROWS(ai, m) (u.pm * 256 + (ai) * 128 + wr * 64 + (m) * 16 + fr)
typedef f32x4 Acc[2][2][4][2];

DI void store8(bf16_t* p, f32x4 v0, f32x4 v1) { u32x4 w; w.x = pk2(v0[0], v0[1]); w.y = pk2(v0[2], v0[3]); w.z = pk2(v1[0], v1[1]); w.w = pk2(v1[2], v1[3]); *(u32x4*)p = w; }
template <bool ISK> DI void epi_rot(const Acc& acc, const Unit& u, int wr, int wc, int fr, int fq, bf16_t* O, bf16_t* KdT, const float* rcos, const float* rsin, int hb) {
    const float sc = ISK ? 0.08838834764831845f : 1.0f;
    const int i0 = 16 * wc + 4 * fq;
#pragma unroll
    for (int ai = 0; ai < 2; ++ai)
#pragma unroll
        for (int m = 0; m < 4; ++m) {
            const int row = EPI_ROWS(ai, m), pos = row & (SEQ - 1), b = row >> 13;
            const f32x4 c4 = *(const f32x4*)(rcos + pos * 64 + i0), s4 = *(const f32x4*)(rsin + pos * 64 + i0);
            u32x2 w1[2], w2[2];
#pragma unroll
            for (int bj = 0; bj < 2; ++bj) {
                const int head = hb + bj;
                const f32x4 x1 = acc[ai][bj][m][0], x2 = acc[ai][bj][m][1];
                const f32x4 o1 = (x1 * c4 - x2 * s4) * sc, o2 = (x1 * s4 + x2 * c4) * sc;
                w1[bj].x = pk2(o1[0], o1[1]); w1[bj].y = pk2(o1[2], o1[3]); w2[bj].x = pk2(o2[0], o2[1]); w2[bj].y = pk2(o2[2], o2[3]);
                if (ISK && !(ABL & 256)) {
                    const float dec = __builtin_amdgcn_exp2f((float)(127 - (pos & 127)) * lg2gamma(head));
                    bf16_t* tp = KdT + ((size_t)((b * 4 + head) * 128 + i0)) * SEQ + pos;
                    tp[0] = f2bf(o1[0] * dec); tp[(size_t)1 * SEQ] = f2bf(o1[1] * dec); tp[(size_t)2 * SEQ] = f2bf(o1[2] * dec); tp[(size_t)3 * SEQ] = f2bf(o1[3] * dec);
                    tp[(size_t)64 * SEQ] = f2bf(o2[0] * dec); tp[(size_t)65 * SEQ] = f2bf(o2[1] * dec); tp[(size_t)66 * SEQ] = f2bf(o2[2] * dec); tp[(size_t)67 * SEQ] = f2bf(o2[3] * dec);
                }
            }
            {
                const auto a0 = __builtin_amdgcn_permlane16_swap(w1[0].x, w1[1].x, false, false), a1 = __builtin_amdgcn_permlane16_swap(w1[0].y, w1[1].y, false, false);
                const auto b0 = __builtin_amdgcn_permlane16_swap(w2[0].x, w2[1].x, false, false), b1 = __builtin_amdgcn_permlane16_swap(w2[0].y, w2[1].y, false, false);
                bf16_t* op = O + (size_t)row * 512 + (hb + (fq & 1)) * 128 + 16 * wc + 8 * (fq >> 1);
                *(u32x4*)op = (u32x4){a0[0], a1[0], a0[1], a1[1]}; *(u32x4*)(op + 64) = (u32x4){b0[0], b1[0], b0[1], b1[1]};
            }
            asm volatile("" ::: "memory");
        }
}
DI void epi_tr(const Acc& acc, const Unit& u, int wr, int wc, int fr, int fq, bf16_t* TP, int nrow_b, int rowoff, int bjmul) {
    char* tb = (char*)TP;
#pragma unroll
    for (int ai = 0; ai < 2; ++ai)
#pragma unroll
        for (int m = 0; m < 4; ++m) {
            const int row = EPI_ROWS(ai, m), pos = row & (SEQ - 1), b = row >> 13;
            const unsigned o0 = (unsigned)((b * nrow_b + rowoff + 8 * fq) * SEQ + pos) * 2u;
#pragma unroll
            for (int bj = 0; bj < 2; ++bj)
#pragma unroll
                for (int n = 0; n < 2; ++n) {
                    const unsigned o = o0 + (unsigned)((bjmul * bj + 4 * n) * SEQ) * 2u;
                    const f32x4 v = acc[ai][bj][m][n];
                    if (!(ABL & 256)) { *(bf16_t*)(tb + o) = f2bf(v[0]); *(bf16_t*)(tb + o + 2u * SEQ) = f2bf(v[1]); *(bf16_t*)(tb + o + 4u * SEQ) = f2bf(v[2]); *(bf16_t*)(tb + o + 6u * SEQ) = f2bf(v[3]); }
                }
            asm volatile("" ::: "memory");
        }
}
template <bool SIL> DI void epi_gate(const Acc& acc, const Unit& u, int wr, int wc, int fr, int fq, bf16_t* O, int cb) {
#pragma unroll
    for (int ai = 0; ai < 2; ++ai)
#pragma unroll
        for (int m = 0; m < 4; ++m) {
            const int row = EPI_ROWS(ai, m);
#pragma unroll
            for (int bj = 0; bj < 2; ++bj) {
                f32x4 v0 = acc[ai][bj][m][0], v1 = acc[ai][bj][m][1];
                if (SIL) { v0 = (f32x4){siluf_(v0[0]), siluf_(v0[1]), siluf_(v0[2]), siluf_(v0[3])}; v1 = (f32x4){siluf_(v1[0]), siluf_(v1[1]), siluf_(v1[2]), siluf_(v1[3])}; }
                else { v0 = (f32x4){sigmoidf_(v0[0]), sigmoidf_(v0[1]), sigmoidf_(v0[2]), sigmoidf_(v0[3])}; v1 = (f32x4){sigmoidf_(v1[0]), sigmoidf_(v1[1]), sigmoidf_(v1[2]), sigmoidf_(v1[3])}; }
                store8(O + (size_t)row * 1024 + cb + 64 * wc + 32 * bj + 8 * fq, v0, v1);
            }
            asm volatile("" ::: "memory");
        }
}
template <int LO> DI void epi_gate_q(const Acc& acc, const Unit& u, int wr, int wc, int fr, int fq, unsigned char* O, int cb) {
#pragma unroll
    for (int ai = 0; ai < 2; ++ai)
#pragma unroll
        for (int m = 0; m < 4; ++m) {
            const int row = EPI_ROWS(ai, m);
            u32x4 w;
#pragma unroll
            for (int bj = 0; bj < 2; ++bj)
#pragma unroll
                for (int n = 0; n < 2; ++n) {
                    const f32x4 v = acc[ai][bj][m][n];
                    unsigned q = 0;
#pragma unroll
                    for (int j = 0; j < 4; ++j) { const float e = __builtin_amdgcn_exp2f(v[j] * -1.4426950408889634f); float f = __builtin_amdgcn_rcpf(__builtin_fmaf(e, 1.0f / 255.0f, 1.0f / 255.0f)); if (LO) f = fmaxf(f, (float)LO); q = __builtin_amdgcn_cvt_pk_u8_f32(f, j, q); }
                    w[2 * bj + n] = q;
                }
            *(u32x4*)(O + (size_t)row * 1024 + cb + 64 * wc + 16 * fq) = w;
            asm volatile("" ::: "memory");
        }
}
DI void epi_qknorm(const Acc& acc, const Unit& u, int wr, int wc, int fr, int fq, bf16_t* O, int pitch, int coff, const float* gw, float sc) {
    const f32x4 g00 = *(const f32x4*)(gw + 8 * fq) * sc, g01 = *(const f32x4*)(gw + 8 * fq + 4) * sc, g10 = *(const f32x4*)(gw + 32 + 8 * fq) * sc, g11 = *(const f32x4*)(gw + 32 + 8 * fq + 4) * sc;
#pragma unroll
    for (int ai = 0; ai < 2; ++ai)
#pragma unroll
        for (int m = 0; m < 4; ++m) {
            const int row = EPI_ROWS(ai, m);
            float ss = 0.f;
#pragma unroll
            for (int bj = 0; bj < 2; ++bj)
#pragma unroll
                for (int n = 0; n < 2; ++n) { const f32x4 v = acc[ai][bj][m][n]; ss += (v[0] * v[0] + v[1] * v[1]) + (v[2] * v[2] + v[3] * v[3]); }
            ss += __shfl_xor(ss, 16); ss += __shfl_xor(ss, 32);
            const float r = __builtin_amdgcn_rsqf(ss * (1.0f / 64.0f) + EPS);
            bf16_t* op = O + (size_t)row * pitch + coff + 8 * fq;
            store8(op, acc[ai][0][m][0] * r * g00, acc[ai][0][m][1] * r * g01);
            store8(op + 32, acc[ai][1][m][0] * r * g10, acc[ai][1][m][1] * r * g11);
            asm volatile("" ::: "memory");
        }
}
struct EpiProj {
    bf16_t *Qr, *Kr, *KdT, *VT, *Gs, *SQ, *SK, *SVT; unsigned char *GA, *GB; const float *rcos, *rsin, *qng, *kng; const float *hs, *csc;
    DI void stage(LAS unsigned char* lds, const Unit& u, int wid, int lane, int par) const {
        const float* src = (wid < 4 ? csc + u.pn * 256 + wid * 64 : hs + u.pm * 256 + (wid - 4) * 64) + lane;
        __builtin_amdgcn_global_load_lds((const unsigned*)src, (LAS unsigned*)(lds + 131072 + 8192 + par * 2048 + wid * 256), 4, 0, 0);
    }
    DI void pre(Acc& acc, const Unit& u, int wr, int wc, int fr, int fq, const LAS float* sc) const {
        f32x4 cs[2][2];
#pragma unroll
        for (int bj = 0; bj < 2; ++bj)
#pragma unroll
            for (int n = 0; n < 2; ++n) cs[bj][n] = *(const LAS f32x4*)(sc + 128 * bj + 32 * wc + 16 * n + 4 * fq);
#pragma unroll
        for (int ai = 0; ai < 2; ++ai)
#pragma unroll
            for (int m = 0; m < 4; ++m) {
                const float rs = sc[256 + ai * 128 + wr * 64 + m * 16 + fr];
#pragma unroll
                for (int bj = 0; bj < 2; ++bj)
#pragma unroll
                    for (int n = 0; n < 2; ++n) {
                        const i32x4 iv = __builtin_bit_cast(i32x4, acc[ai][bj][m][n]);
                        f32x4 v; v[0] = (float)iv[0]; v[1] = (float)iv[1]; v[2] = (float)iv[2]; v[3] = (float)iv[3];
                        acc[ai][bj][m][n] = v * cs[bj][n] * rs;
                    }
            }
    }
    DI void operator()(const Acc& acc, const Unit& u, int wr, int wc, int fr, int fq) const {
        const int pn = u.pn;
        if (pn < 2) epi_rot<false>(acc, u, wr, wc, fr, fq, Qr, nullptr, rcos, rsin, 2 * pn);
        else if (pn < 4) epi_rot<true>(acc, u, wr, wc, fr, fq, Kr, KdT, rcos, rsin, 2 * (pn - 2));
        else if (pn < 8) epi_tr(acc, u, wr, wc, fr, fq, VT, 1024, (pn - 4) * 256 + 64 * wc, 32);
        else if (pn < 12) epi_gate<true>(acc, u, wr, wc, fr, fq, Gs, (pn - 8) * 256);
        else if (pn < 14) epi_qknorm(acc, u, wr, wc, fr, fq, SQ, 512, ((pn - 12) * 4 + wc) * 64, qng, 0.125f);
        else if (pn == 14) {
            if (wc < 2) epi_qknorm(acc, u, wr, wc, fr, fq, SK, 128, wc * 64, kng, 1.0f);
            else epi_tr(acc, u, wr, wc, fr, fq, SVT, 128, (wc - 2) * 64, 32);
        }
        else if (pn < 19) epi_gate_q<0>(acc, u, wr, wc, fr, fq, GA, (pn - 15) * 256);
        else epi_gate_q<1>(acc, u, wr, wc, fr, fq, GB, (pn - 19) * 256);
    }
};

struct EpiMerge {
    const unsigned char* GA; const unsigned char* GB; bf16_t* MG;
    DI void mid(Acc& acc, const Unit& u, int wr, int wc, int fr, int fq) const {
        u32x2 a[2][4][2], b[2][4][2];
#pragma unroll
        for (int ai = 0; ai < 2; ++ai)
#pragma unroll
            for (int m = 0; m < 4; ++m)
#pragma unroll
                for (int bj = 0; bj < 2; ++bj) { const size_t o = (size_t)EPI_ROWS(ai, m) * 1024 + u.pn * 256 + 64 * wc + 16 * fq + 8 * bj;
                    if (ABL & 1) { a[ai][m][bj] = (u32x2){0x01010101u, 0x01010101u}; b[ai][m][bj] = a[ai][m][bj]; } else { a[ai][m][bj] = *(const u32x2*)(GA + o); b[ai][m][bj] = *(const u32x2*)(GB + o); } }
#pragma unroll
        for (int ai = 0; ai < 2; ++ai)
#pragma unroll
            for (int m = 0; m < 4; ++m)
#pragma unroll
                for (int bj = 0; bj < 2; ++bj) {
                    const u32x2 av = a[ai][m][bj], bv = b[ai][m][bj];
                    f32x4 r0, r1;
#pragma unroll
                    for (int j = 0; j < 4; ++j) {
                        r0[j] = (float)((av.x >> (8 * j)) & 255u) * __builtin_amdgcn_rcpf((float)((bv.x >> (8 * j)) & 255u));
                        r1[j] = (float)((av.y >> (8 * j)) & 255u) * __builtin_amdgcn_rcpf((float)((bv.y >> (8 * j)) & 255u));
                    }
                    acc[ai][bj][m][0] = acc[ai][bj][m][0] * r0; acc[ai][bj][m][1] = acc[ai][bj][m][1] * r1;
                }
    }
    DI void operator()(const Acc& acc, const Unit& u, int wr, int wc, int fr, int fq) const {
        u32x2 gv[2][4][2];
#pragma unroll
        for (int ai = 0; ai < 2; ++ai)
#pragma unroll
            for (int m = 0; m < 4; ++m)
#pragma unroll
                for (int bj = 0; bj < 2; ++bj) gv[ai][m][bj] = (ABL & 2) ? (u32x2){0x01010101u, 0x01010101u} : *(const u32x2*)(GB + (size_t)EPI_ROWS(ai, m) * 1024 + u.pn * 256 + 64 * wc + 16 * fq + 8 * bj);
#pragma unroll
        for (int ai = 0; ai < 2; ++ai) {
#pragma unroll
            for (int m = 0; m < 4; ++m)
#pragma unroll
                for (int bj = 0; bj < 2; ++bj) {
                    const size_t o = (size_t)EPI_ROWS(ai, m) * 1024 + u.pn * 256 + 64 * wc + 16 * fq + 8 * bj;
                    const u32x2 g = gv[ai][m][bj];
                    const f32x4 a0 = acc[ai][bj][m][0] * (1.0f / 255.0f), a1 = acc[ai][bj][m][1] * (1.0f / 255.0f);
                    float v[8];
#pragma unroll
                    for (int j = 0; j < 4; ++j) { v[j] = (float)((g.x >> (8 * j)) & 255u) * a0[j]; v[4 + j] = (float)((g.y >> (8 * j)) & 255u) * a1[j]; }
                    u32x4 w; w.x = pk2(v[0], v[1]); w.y = pk2(v[2], v[3]); w.z = pk2(v[4], v[5]); w.w = pk2(v[6], v[7]);
                    *(u32x4*)(MG + o) = w;
                }
            asm volatile("" ::: "memory");
        }
    }
};

struct EpiOut {
    const float* x; bf16_t* XB; float* SS;
    DI void operator()(const Acc& acc, const Unit& u, int wr, int wc, int fr, int fq) const {
#pragma unroll
        for (int ai = 0; ai < 2; ++ai) {
            f32x4 xv[4][2][2];
#pragma unroll
            for (int m = 0; m < 4; ++m)
#pragma unroll
                for (int bj = 0; bj < 2; ++bj) { const size_t o = (size_t)EPI_ROWS(ai, m) * 1024 + u.pn * 256 + 64 * wc + 32 * bj + 8 * fq; if (ABL & 8) { xv[m][bj][0] = (f32x4){0.f, 0.f, 0.f, 0.f}; xv[m][bj][1] = xv[m][bj][0]; } else { xv[m][bj][0] = *(const f32x4*)(x + o); xv[m][bj][1] = *(const f32x4*)(x + o + 4); } }
#pragma unroll
            for (int m = 0; m < 4; ++m) {
                const int row = EPI_ROWS(ai, m);
                float ss = 0.f;
#pragma unroll
                for (int bj = 0; bj < 2; ++bj) {
                    const size_t o = (size_t)row * 1024 + u.pn * 256 + 64 * wc + 32 * bj + 8 * fq;
                    const f32x4 x0 = xv[m][bj][0] + acc[ai][bj][m][0], x1 = xv[m][bj][1] + acc[ai][bj][m][1];
                    ss += (x0[0] * x0[0] + x0[1] * x0[1]) + (x0[2] * x0[2] + x0[3] * x0[3]) + (x1[0] * x1[0] + x1[1] * x1[1]) + (x1[2] * x1[2] + x1[3] * x1[3]);
                    u32x4 w; w.x = pk2(x0[0], x0[1]); w.y = pk2(x0[2], x0[3]); w.z = pk2(x1[0], x1[1]); w.w = pk2(x1[2], x1[3]);
                    *(u32x4*)(XB + o) = w;
                }
                ss += __shfl_xor(ss, 16); ss += __shfl_xor(ss, 32);
                if (fq == 0) SS[(size_t)row * 16 + u.pn * 4 + wc] = ss;
            }
            asm volatile("" ::: "memory");
        }
    }
};

struct EpiRouter {
    float* LOG;
    DI void operator()(const Acc& acc, const Unit& u, int wr, int wc, int fr, int fq) const {
        if (wc != 0) return;
#pragma unroll
        for (int ai = 0; ai < 2; ++ai)
#pragma unroll
            for (int m = 0; m < 4; ++m) {
                const int row = EPI_ROWS(ai, m);
#pragma unroll
                for (int bj = 0; bj < 2; ++bj) { float* p = LOG + (size_t)row * 64 + 32 * bj + 8 * fq; *(f32x4*)p = acc[ai][bj][m][0]; *(f32x4*)(p + 4) = acc[ai][bj][m][1]; }
            }
    }
};

struct EpiUp {
    bf16_t* HM; const LAS int* tab; const f32x2* lrx; const float* ecs;
    DI void stage(LAS unsigned char*, const Unit&, int, int, int) const {}
    DI void pre(Acc& acc, const Unit& u, int wr, int wc, int fr, int fq, const LAS float*) const {
        const int cnt = tab[u.g];
        float rs[2][4];
#pragma unroll
        for (int ai = 0; ai < 2; ++ai)
#pragma unroll
            for (int m = 0; m < 4; ++m) { const int rank = u.aux * 256 + ai * 128 + wr * 64 + m * 16 + fr; rs[ai][m] = lrx[(size_t)u.g * LCAP + (rank < cnt ? rank : 0)].y; }
#pragma unroll
        for (int bj = 0; bj < 2; ++bj)
#pragma unroll
            for (int n = 0; n < 2; ++n) {
                const f32x4 cs = *(const f32x4*)(ecs + (u.g & 31) * 1024 + u.pn * 256 + 128 * bj + 32 * wc + 16 * n + 4 * fq);
#pragma unroll
                for (int ai = 0; ai < 2; ++ai)
#pragma unroll
                    for (int m = 0; m < 4; ++m) {
                        const i32x4 iv = __builtin_bit_cast(i32x4, acc[ai][bj][m][n]);
                        f32x4 v; v[0] = (float)iv[0]; v[1] = (float)iv[1]; v[2] = (float)iv[2]; v[3] = (float)iv[3];
                        acc[ai][bj][m][n] = v * cs * rs[ai][m];
                    }
                asm volatile("" ::: "memory");
            }
    }
    DI void operator()(const Acc& acc, const Unit& u, int wr, int wc, int fr, int fq) const {
        const int cnt = tab[u.g];
        float rv[2][4];
#pragma unroll
        for (int ai = 0; ai < 2; ++ai)
#pragma unroll
            for (int m = 0; m < 4; ++m) { const int rank = u.aux * 256 + ai * 128 + wr * 64 + m * 16 + fr; rv[ai][m] = lrx[(size_t)u.g * LCAP + (rank < cnt ? rank : 0)].x; }
#pragma unroll
        for (int ai = 0; ai < 2; ++ai)
#pragma unroll
            for (int m = 0; m < 4; ++m) {
                const int lr = ai * 128 + wr * 64 + m * 16 + fr, rank = u.aux * 256 + lr;
                if (rank < cnt && (u.half == 0 || u.half == ai + 1)) {
                    const float r = rv[ai][m];
                    float v[8];
#pragma unroll
                    for (int n = 0; n < 2; ++n)
#pragma unroll
                        for (int j = 0; j < 4; ++j) { const float g = acc[ai][0][m][n][j] * r, up = acc[ai][1][m][n][j] * r; v[4 * n + j] = siluf_(g) * up; }
                    u32x4 w; w.x = pk2(v[0], v[1]); w.y = pk2(v[2], v[3]); w.z = pk2(v[4], v[5]); w.w = pk2(v[6], v[7]);
                    *(u32x4*)(HM + (size_t)(u.pm * 256 + lr) * DFF + u.pn * 128 + 32 * wc + 8 * fq) = w;
                }
            }
    }
};

struct XcdBarrier;
__device__ __forceinline__ void xcd_wait(const XcdBarrier& b, volatile LAS unsigned* sv);
template <int SLOT> struct EpiDown {
    const bf16_t* In; bf16_t* YB; float* out; const LAS int* tab; const int* ltok; const float* lw; const XcdBarrier* xb; volatile LAS unsigned* sv;
    DI void operator()(const Acc& acc, const Unit& u, int wr, int wc, int fr, int fq) const {
        const int cnt = tab[u.g];
        if (SLOT == 1) { if (sv[3] == 0u) { xcd_wait(*xb, sv); if (threadIdx.x == 0) sv[3] = 1u; asm volatile("s_waitcnt lgkmcnt(0)" ::: "memory"); __builtin_amdgcn_s_barrier(); } }
        int tk[2][4]; float wv[2][4];
#pragma unroll
        for (int ai = 0; ai < 2; ++ai)
#pragma unroll
            for (int m = 0; m < 4; ++m) { const int rank = u.aux * 256 + ai * 128 + wr * 64 + m * 16 + fr; const size_t li = (size_t)u.g * LCAP + (rank < cnt ? rank : 0); tk[ai][m] = ltok[li]; wv[ai][m] = lw[li]; }
        u32x4 bv[2][4][2];
#pragma unroll
        for (int ai = 0; ai < 2; ++ai)
#pragma unroll
            for (int m = 0; m < 4; ++m)
#pragma unroll
                for (int bj = 0; bj < 2; ++bj) bv[ai][m][bj] = (ABL & 4) ? (u32x4){0u, 0u, 0u, 0u} : *(const u32x4*)(In + (size_t)tk[ai][m] * 1024 + u.pn * 256 + 64 * wc + 32 * bj + 8 * fq);
#pragma unroll
        for (int ai = 0; ai < 2; ++ai) {
#pragma unroll
            for (int m = 0; m < 4; ++m) {
                const int rank = u.aux * 256 + ai * 128 + wr * 64 + m * 16 + fr;
                if (rank < cnt && (u.half == 0 || u.half == ai + 1)) {
                    const float w = wv[ai][m];
#pragma unroll
                    for (int bj = 0; bj < 2; ++bj) {
                        const size_t o = (size_t)tk[ai][m] * 1024 + u.pn * 256 + 64 * wc + 32 * bj + 8 * fq;
                        const u32x4 b = bv[ai][m][bj];
                        const f32x4 a0 = acc[ai][bj][m][0] * w, a1 = acc[ai][bj][m][1] * w;
                        const f32x4 o0 = (f32x4){bflo(b.x), bfhi(b.x), bflo(b.y), bfhi(b.y)} + a0, o1 = (f32x4){bflo(b.z), bfhi(b.z), bflo(b.w), bfhi(b.w)} + a1;
                        if (SLOT == 0) { u32x4 wvv; wvv.x = pk2(o0[0], o0[1]); wvv.y = pk2(o0[2], o0[3]); wvv.z = pk2(o1[0], o1[1]); wvv.w = pk2(o1[2], o1[3]); *(u32x4*)(YB + o) = wvv; }
                        else { *(f32x4*)(out + o) = o0; *(f32x4*)(out + o + 4) = o1; }
                    }
                }
            }
            asm volatile("" ::: "memory");
        }
    }
};

#define XB_TMO      128
#define XB_XCNT(j)  (256  + 64 * (j))
#define XB_XSUB(j)  (1280 + 64 * (j))
#define XB_XGEN(j)  (2304 + 64 * (j))
#define XB_TOP      3328
#define XB_TOPGEN   3392
#define XCD_BAR_WORDS 3456
#define XB_SPIN_CAP (1u << 20)
DI unsigned xb_ld(unsigned* p)              { return __hip_atomic_load(p, __ATOMIC_RELAXED, __HIP_MEMORY_SCOPE_AGENT); }
DI unsigned xb_add(unsigned* p, unsigned v) { return __hip_atomic_fetch_add(p, v, __ATOMIC_RELAXED, __HIP_MEMORY_SCOPE_AGENT); }
DI unsigned xb_xcc_id() { return (unsigned)__builtin_amdgcn_s_getreg((3 << 11) | 20) & 0xFu; }
#define XB_SPIN(cond, bar) do { unsigned _sp = 0; while (cond) { __builtin_amdgcn_s_sleep(1); \
    if ((++_sp & 255u) == 0u) { if (xb_ld(&(bar)[XB_TMO])) break; if (_sp > XB_SPIN_CAP) { atomicAdd(&(bar)[XB_TMO], 1u); break; } } } } while (0)
struct XcdBarrier { unsigned* bar; unsigned x; volatile LAS unsigned* st; };
DI XcdBarrier xcd_barrier_post(unsigned* bar, volatile LAS unsigned* st) {
    XcdBarrier b; b.bar = bar; b.x = xb_xcc_id(); b.st = st;
    if (threadIdx.x == 0) (void)xb_add(&bar[XB_XCNT(b.x)], 1u);
    return b;
}
DI void xcd_barrier_complete(unsigned* bar, unsigned x, unsigned& nloc, unsigned& nx) {
    const unsigned G = gridDim.x * gridDim.y * gridDim.z;
    unsigned sum, cnt, mine, sp = 0u;
    for (;;) {
        sum = 0u; cnt = 0u; mine = 0u;
#pragma unroll
        for (unsigned j = 0; j < 16; ++j) { const unsigned c = xb_ld(&bar[XB_XCNT(j)]); sum += c; cnt += (c > 0u) ? 1u : 0u; mine = (j == x) ? c : mine; }
        if (sum == G) break;
        __builtin_amdgcn_s_sleep(1);
        if ((++sp & 255u) == 0u) { if (xb_ld(&bar[XB_TMO])) break; if (sp > XB_SPIN_CAP) { atomicAdd(&bar[XB_TMO], 1u); break; } }
    }
    nloc = mine > 0u ? mine : 1u; nx = cnt > 0u ? cnt : 1u;
}
DI void xcd_barrier(const XcdBarrier& b) {
    asm volatile("s_waitcnt vmcnt(0)" ::: "memory");
    __syncthreads();
    if (threadIdx.x == 0) {
        unsigned* bar = b.bar;
        __builtin_amdgcn_s_waitcnt(0);
        unsigned nloc = b.st[0], nx = b.st[1];
        if (nloc == 0u) { xcd_barrier_complete(bar, b.x, nloc, nx); b.st[0] = nloc; b.st[1] = nx; }
        const unsigned old = xb_add(&bar[XB_XSUB(b.x)], 1u);
        const unsigned gen = old / nloc;
        if (old + 1u == (gen + 1u) * nloc) {
            __builtin_amdgcn_fence(__ATOMIC_RELEASE, "agent");
            asm volatile("s_waitcnt vmcnt(0)" ::: "memory");
            const unsigned og = xb_add(&bar[XB_TOP], 1u);
            const unsigned tg = og / nx;
            if (og + 1u == (tg + 1u) * nx) xb_add(&bar[XB_TOPGEN], 1u);
            else XB_SPIN((int)(xb_ld(&bar[XB_TOPGEN]) - tg) <= 0, bar);
        } else {
            XB_SPIN((int)(xb_ld(&bar[XB_TOPGEN]) - gen) <= 0, bar);
        }
        __builtin_amdgcn_fence(__ATOMIC_ACQUIRE, "agent");
        asm volatile("s_waitcnt vmcnt(0)" ::: "memory");
    }
    __syncthreads();
}


DI void xcd_arrive(const XcdBarrier& b, volatile LAS unsigned* sv) {
    asm volatile("s_waitcnt vmcnt(0)" ::: "memory");
    __syncthreads();
    if (threadIdx.x == 0) {
        unsigned* bar = b.bar;
        __builtin_amdgcn_s_waitcnt(0);
        unsigned nloc = b.st[0], nx = b.st[1];
        if (nloc == 0u) { xcd_barrier_complete(bar, b.x, nloc, nx); b.st[0] = nloc; b.st[1] = nx; }
        const unsigned old = xb_add(&bar[XB_XSUB(b.x)], 1u);
        const unsigned gen = old / nloc;
        sv[1] = gen;
        if (old + 1u == (gen + 1u) * nloc) {
            __builtin_amdgcn_fence(__ATOMIC_RELEASE, "agent");
            asm volatile("s_waitcnt vmcnt(0)" ::: "memory");
            const unsigned og = xb_add(&bar[XB_TOP], 1u);
            const unsigned tg = og / nx;
            if (og + 1u == (tg + 1u) * nx) xb_add(&bar[XB_TOPGEN], 1u);
            sv[0] = 1u; sv[2] = tg;
        } else sv[0] = 0u;
    }
    __syncthreads();
}
DI void xcd_wait(const XcdBarrier& b, volatile LAS unsigned* sv) {
    if (threadIdx.x == 0) {
        unsigned* bar = b.bar;
        const unsigned gen = sv[1];
        XB_SPIN((int)(xb_ld(&bar[XB_TOPGEN]) - gen) <= 0, bar);
        __builtin_amdgcn_fence(__ATOMIC_ACQUIRE, "agent");
        asm volatile("s_waitcnt vmcnt(0)" ::: "memory");
    }
    asm volatile("s_waitcnt lgkmcnt(0)" ::: "memory");
    __builtin_amdgcn_s_barrier();
}

template <int RB> DI int swz(int row, int chunk) { return row * RB + ((RB == 128 ? (chunk ^ ((row >> 1) & 7)) : (chunk ^ (row & 15))) << 4); }
template <int RB> DI void stage_tile(LAS unsigned char* lds, int loff, const char* g, size_t gpitch, int nrows, int wave, int lane) {
    constexpr int RPI = 1024 / RB, LPR = RB / 16;
    for (int r0 = wave * RPI; r0 < nrows; r0 += 8 * RPI) {
        const int row = r0 + lane / LPR, slot = lane % LPR;
        const int chunk = RB == 128 ? (slot ^ ((row >> 1) & 7)) : (slot ^ (row & 15));
        __builtin_amdgcn_global_load_lds((const unsigned*)(g + (size_t)row * gpitch + chunk * 16), (LAS unsigned*)(lds + loff + r0 * RB), 16, 0, 0);
    }
}
#define LDS_V16(off) (*(const LAS bf16x8*)(lds + (off)))
#define LDS_V8(off) (*(const LAS u32x2*)(lds + (off)))

struct Args {
    const float *x, *norm_mix_g, *w_in, *ret_gn_g, *w_ret_o, *q_norm_g, *k_norm_g, *sinks, *w_swa_o, *w_out, *norm_ffn_g, *w_rg, *b_rg, *w_re, *b_re, *w_gate, *w_up, *w_down;
    float* out; unsigned char* ws;
};

struct TrItem { f32x4 v[8]; float sc[8]; bf16_t* WT; int K, p0, k0; };
__device__ const float k_ones[1024] = {
#define O16 1.f,1.f,1.f,1.f,1.f,1.f,1.f,1.f,1.f,1.f,1.f,1.f,1.f,1.f,1.f,1.f
#define O256 O16,O16,O16,O16,O16,O16,O16,O16,O16,O16,O16,O16,O16,O16,O16,O16
    O256, O256, O256, O256
#undef O256
#undef O16
};
DI void tr_load(TrItem& t, const float* colp4, int ldn, bf16_t* WT, int K, int p0, int k0, int lane, const float* ks) {
    t.WT = WT; t.K = K; t.p0 = p0; t.k0 = k0;
#pragma unroll
    for (int i = 0; i < 8; ++i) t.v[i] = *(const f32x4*)(colp4 + (size_t)(k0 + i * 8 + (lane >> 3)) * ldn);
#pragma unroll
    for (int i = 0; i < 8; ++i) t.sc[i] = ((const __attribute__((address_space(1))) float*)ks)[k0 + i * 8 + (lane >> 3)];
}
DI void tr_finish(const TrItem& t, LAS float* scr, int lane) {
    const int c4 = lane & 7;
#pragma unroll
    for (int i = 0; i < 8; ++i) { LAS float* d = scr + (i * 8 + (lane >> 3)) * 33 + 4 * c4; const float sc = t.sc[i]; d[0] = t.v[i][0] * sc; d[1] = t.v[i][1] * sc; d[2] = t.v[i][2] * sc; d[3] = t.v[i][3] * sc; }
    asm volatile("s_waitcnt lgkmcnt(0)" ::: "memory");
    const int c = lane & 7;
#pragma unroll
    for (int j = 0; j < 4; ++j) { const int n = (lane >> 3) + 8 * j; const LAS float* s = scr + (8 * c) * 33 + n;
        u32x4 o; o.x = pk2(s[0 * 33], s[1 * 33]); o.y = pk2(s[2 * 33], s[3 * 33]); o.z = pk2(s[4 * 33], s[5 * 33]); o.w = pk2(s[6 * 33], s[7 * 33]);
        *(u32x4*)(t.WT + (size_t)(t.p0 + n) * t.K + t.k0 + 8 * c) = o; }
    asm volatile("s_waitcnt lgkmcnt(0)" ::: "memory");
}
DI void sincos_d(double a, double& s, double& c) {
    const double q = __builtin_rint(a * 0.63661977236758134308);
    const double r = (a - q * 1.57079632679489655800) - q * 6.12323399573676603587e-17;
    const double r2 = r * r;
    double sp = r * (1.0 + r2 * (-1.0 / 6 + r2 * (1.0 / 120 + r2 * (-1.0 / 5040 + r2 * (1.0 / 362880 + r2 * (-1.0 / 39916800 + r2 * (1.0 / 6227020800.0)))))));
    double cp = 1.0 + r2 * (-0.5 + r2 * (1.0 / 24 + r2 * (-1.0 / 720 + r2 * (1.0 / 40320 + r2 * (-1.0 / 3628800 + r2 * (1.0 / 479001600.0 + r2 * (-1.0 / 87178291200.0)))))));
    const int qi = ((int)q) & 3;
    s = (qi == 0) ? sp : (qi == 1) ? cp : (qi == 2) ? -sp : -cp;
    c = (qi == 0) ? cp : (qi == 1) ? -sp : (qi == 2) ? -cp : sp;
}

constexpr int CEXP0 = 12288, CEXP1 = 8192;
constexpr int CI0 = 16 * 184, CI1 = 16 * 32, CI2 = 8 * 32, CI3 = 16 * 32, CI4 = 16 * 2, CIU = 32 * 16 * 32, CID = 32 * 8 * 32, CNS = CI0 + CI1 + CI2 + CI3 + CI4, CNI = CNS + CIU + CID;
DI void conv_items(const Args& A, unsigned char* ws, LAS float* scr, int lane, int lo, int hi, int w0, int nw) {
    bf16_t* WinT = (bf16_t*)(ws + WS_WIN); bf16_t* WretoT = (bf16_t*)(ws + WS_WRETO); bf16_t* WoutT = (bf16_t*)(ws + WS_WOUT); bf16_t* WrT = (bf16_t*)(ws + WS_WR);
    bf16_t* Wgu = (bf16_t*)(ws + WS_WGU); bf16_t* WdT = (bf16_t*)(ws + WS_WDT);
    constexpr int I0 = CI0, I1 = CI1, I2 = CI2, I3 = CI3, I4 = CI4, IU = CIU;
    const int c4 = lane & 7;
    auto issue = [&](TrItem& t, int it) {
        int r = it;
        const float* src; int ldn, K, p0, k0; bf16_t* WT; const float* ks = k_ones;
        if (r < I0) { const int kb = r / 184, pb = r % 184, p = pb * 32 + 4 * c4, tile = p >> 8;
            src = A.w_in + tile * 256 + (tile < 4 ? colmap_rot(p & 255) : (tile >= 15 ? colmap_gate(p & 255) : colmap_std(p & 255))); ldn = INW; WT = WinT; K = 1024; p0 = pb * 32; k0 = kb * 64; }
        else if ((r -= I0) < I1) { const int kb = r / 32, pb = r % 32, p = pb * 32 + 4 * c4;
            src = A.w_ret_o + (p & ~255) + colmap_gate(p & 255); ldn = 1024; WT = WretoT; K = 1536; p0 = pb * 32; k0 = kb * 64; }
        else if ((r -= I1) < I2) { const int kb = r / 32, pb = r % 32, p = pb * 32 + 4 * c4;
            src = A.w_swa_o + (p & ~255) + colmap_gate(p & 255); ldn = 1024; WT = WretoT + 1024; K = 1536; p0 = pb * 32; k0 = kb * 64; }
        else if ((r -= I2) < I3) { const int kb = r / 32, pb = r % 32, p = pb * 32 + 4 * c4;
            src = A.w_out + (p & ~255) + colmap_std(p & 255); ldn = 1024; WT = WoutT; K = 1024; p0 = pb * 32; k0 = kb * 64; }
        else if ((r -= I3) < I4) { const int kb = r / 2, bj = r % 2, pb = 4 * bj, p = pb * 32 + 4 * c4; const int L = colmap_std(p);
            const int Lc = L < 36 ? L : 32;
            src = Lc < 4 ? A.w_rg + Lc : A.w_re + (Lc - 4); ldn = Lc < 4 ? 4 : 32; WT = WrT; K = 1024; p0 = pb * 32; k0 = kb * 64; ks = A.norm_ffn_g; }
        else if ((r -= I4) < IU) { const int e = r >> 9, rr = r & 511, kb = rr >> 5, pb = rr & 31, p = pb * 32 + 4 * c4;
            const int pl = p & 255, bj = pl >> 7, wc = (pl >> 5) & 3, n = (pl >> 4) & 1, fq = (pl >> 2) & 3;
            const int ffc = 128 * (p >> 8) + 32 * wc + 8 * fq + 4 * n;
            src = (bj == 0 ? A.w_gate : A.w_up) + (size_t)e * 1024 * 512 + ffc; ldn = 512; WT = Wgu + (size_t)e * 1024 * 1024; K = 1024; p0 = pb * 32; k0 = kb * 64; ks = A.norm_ffn_g; }
        else { r -= IU; const int e = r >> 8, rr = r & 255, kb = rr >> 5, pb = rr & 31, p = pb * 32 + 4 * c4;
            src = A.w_down + (size_t)e * 512 * 1024 + (p & ~255) + colmap_std(p & 255); ldn = 1024; WT = WdT + (size_t)e * 1024 * 512; K = 512; p0 = pb * 32; k0 = kb * 64; }
        tr_load(t, src, ldn, WT, K, p0, k0, lane, ks);
    };
    auto idx = [&](int j) { return lo + w0 + j * nw; };
    const int n = (hi - lo - w0 + nw - 1) / nw;
    if (n <= 0) return;
    TrItem ta, tb;
    issue(ta, idx(0));
    int j = 0;
    for (; j + 2 < n; j += 2) {
        issue(tb, idx(j + 1));
        tr_finish(ta, scr, lane);
        issue(ta, idx(j + 2));
        tr_finish(tb, scr, lane);
    }
    if (n - j == 2) { issue(tb, idx(j + 1)); tr_finish(ta, scr, lane); tr_finish(tb, scr, lane); }
    else tr_finish(ta, scr, lane);
}

constexpr int CMAX_W = 9216;
DI int win_logical(int p) { const int tile = p >> 8; return tile * 256 + (tile < 4 ? colmap_rot(p & 255) : (tile >= 15 ? colmap_gate(p & 255) : colmap_std(p & 255))); }
DI void win_colmax(const Args& A, unsigned char* ws, int lane, int w0, int nw) {
    unsigned* cmax = (unsigned*)(ws + WS_CTL) + CMAX_W;
    for (int t = w0; t < 32 * 23; t += nw) {
        const int kb = t / 23, cb = t % 23;
        const float* src = A.w_in + (size_t)(kb * 32) * INW + cb * 256 + 4 * lane;
        f32x4 m = {0.f, 0.f, 0.f, 0.f};
#pragma unroll 16
        for (int r = 0; r < 32; ++r) { const f32x4 v = *(const f32x4*)(src + (size_t)r * INW); m[0] = fmaxf(m[0], fabsf(v[0])); m[1] = fmaxf(m[1], fabsf(v[1])); m[2] = fmaxf(m[2], fabsf(v[2])); m[3] = fmaxf(m[3], fabsf(v[3])); }
#pragma unroll
        for (int j = 0; j < 4; ++j) (void)__hip_atomic_fetch_max(&cmax[cb * 256 + 4 * lane + j], __float_as_uint(m[j]), __ATOMIC_RELAXED, __HIP_MEMORY_SCOPE_AGENT);
    }
}
DI void conv_win_i8(const Args& A, unsigned char* ws, LAS float* scr, int lane, int w0, int nw) {
    signed char* W8 = (signed char*)(ws + WS_WIN); const unsigned* cmax = (const unsigned*)(ws + WS_CTL) + CMAX_W; float* csc = (float*)(ws + WS_SS);
    const int c4 = lane & 7, kr = lane >> 3, n = lane >> 1, half = lane & 1;
    for (int it = w0; it < 16 * 184; it += nw) {
        const int kb = it / 184, pb = it % 184, k0 = kb * 64, p0 = pb * 32;
        const float* src = A.w_in + win_logical(p0 + 4 * c4);
        f32x4 v[8];
#pragma unroll
        for (int i = 0; i < 8; ++i) v[i] = *(const f32x4*)(src + (size_t)(k0 + i * 8 + kr) * INW);
        const float amax = fmaxf(__uint_as_float(cmax[win_logical(p0 + n)]), 1e-30f);
        const float qs = 127.0f * __builtin_amdgcn_rcpf(amax);
#pragma unroll
        for (int i = 0; i < 8; ++i) { LAS float* d = scr + (i * 8 + kr) * 33 + 4 * c4; d[0] = v[i][0]; d[1] = v[i][1]; d[2] = v[i][2]; d[3] = v[i][3]; }
        asm volatile("s_waitcnt lgkmcnt(0)" ::: "memory");
        u32x4 o[2];
#pragma unroll
        for (int q = 0; q < 8; ++q) {
            unsigned w = 0;
#pragma unroll
            for (int b = 0; b < 4; ++b) { const float f = scr[(32 * half + 4 * q + b) * 33 + n] * qs; const int c = (int)__builtin_rintf(fminf(fmaxf(f, -127.0f), 127.0f)); w |= ((unsigned)c & 255u) << (8 * b); }
            o[q >> 2][q & 3] = w;
        }
        signed char* dst = W8 + (size_t)(p0 + n) * 1024 + k0 + 32 * half;
        *(u32x4*)dst = o[0]; *(u32x4*)(dst + 16) = o[1];
        if (kb == 0 && half == 0) csc[p0 + n] = amax * (1.0f / 127.0f);
        asm volatile("s_waitcnt lgkmcnt(0)" ::: "memory");
    }
}

constexpr size_t CTL_ECS = 196608;
constexpr size_t CTL_XS = 327680;
DI void quant_wgu(unsigned char* ws, int lane, int r0, int r1, int w0, int nw) {
    unsigned char* W = ws + WS_WGU; float* ecs = (float*)(ws + WS_CTL + CTL_ECS);
    for (int row = r0 + w0; row < r1; row += 2 * nw) {
        const int row2 = row + nw < r1 ? row + nw : row;
        const u32x4 a0 = *(const u32x4*)(W + (size_t)row * 2048 + lane * 32), a1 = *(const u32x4*)(W + (size_t)row * 2048 + lane * 32 + 16);
        const u32x4 b0 = *(const u32x4*)(W + (size_t)row2 * 2048 + lane * 32), b1 = *(const u32x4*)(W + (size_t)row2 * 2048 + lane * 32 + 16);
        float ma = 0.f, mb = 0.f;
#pragma unroll
        for (int i = 0; i < 4; ++i) { const unsigned p = a0[i] & 0x7fff7fffu, q = a1[i] & 0x7fff7fffu, r = b0[i] & 0x7fff7fffu, t = b1[i] & 0x7fff7fffu;
            ma = fmaxf(ma, fmaxf(fmaxf(bflo(p), bfhi(p)), fmaxf(bflo(q), bfhi(q)))); mb = fmaxf(mb, fmaxf(fmaxf(bflo(r), bfhi(r)), fmaxf(bflo(t), bfhi(t)))); }
        ma = fmaxf(wave_max(ma), 1e-30f); mb = fmaxf(wave_max(mb), 1e-30f);
        const float qa = 127.0f * __builtin_amdgcn_rcpf(ma), qb = 127.0f * __builtin_amdgcn_rcpf(mb);
        u32x4 oa, ob;
#pragma unroll
        for (int i = 0; i < 4; ++i) {
            const unsigned pa = i < 2 ? a0[2 * i] : a1[2 * i - 4], pb_ = i < 2 ? a0[2 * i + 1] : a1[2 * i - 3], ra = i < 2 ? b0[2 * i] : b1[2 * i - 4], rb = i < 2 ? b0[2 * i + 1] : b1[2 * i - 3];
            unsigned x = 0u, y = 0u;
            x = __builtin_amdgcn_cvt_pk_u8_f32(__builtin_fmaf(bflo(pa), qa, 128.0f), 0, x); x = __builtin_amdgcn_cvt_pk_u8_f32(__builtin_fmaf(bfhi(pa), qa, 128.0f), 1, x);
            x = __builtin_amdgcn_cvt_pk_u8_f32(__builtin_fmaf(bflo(pb_), qa, 128.0f), 2, x); x = __builtin_amdgcn_cvt_pk_u8_f32(__builtin_fmaf(bfhi(pb_), qa, 128.0f), 3, x);
            y = __builtin_amdgcn_cvt_pk_u8_f32(__builtin_fmaf(bflo(ra), qb, 128.0f), 0, y); y = __builtin_amdgcn_cvt_pk_u8_f32(__builtin_fmaf(bfhi(ra), qb, 128.0f), 1, y);
            y = __builtin_amdgcn_cvt_pk_u8_f32(__builtin_fmaf(bflo(rb), qb, 128.0f), 2, y); y = __builtin_amdgcn_cvt_pk_u8_f32(__builtin_fmaf(bfhi(rb), qb, 128.0f), 3, y);
            oa[i] = x ^ 0x80808080u; ob[i] = y ^ 0x80808080u;
        }
        asm volatile("s_waitcnt vmcnt(0)" ::: "memory");
        *(u32x4*)(W + (size_t)row * 2048 + lane * 16) = oa; if (row2 != row) *(u32x4*)(W + (size_t)row2 * 2048 + lane * 16) = ob;
        if (lane == 0) { ecs[row] = ma * (1.0f / 127.0f); ecs[row2] = mb * (1.0f / 127.0f); }
    }
}

DI void conv_expert_items(const Args& A, unsigned char* ws, LAS float* scr, int lane, int lo, int hi, int w0, int nw) {
    bf16_t* Wgu = (bf16_t*)(ws + WS_WGU); bf16_t* WdT = (bf16_t*)(ws + WS_WDT);
    const int c4 = lane & 7;
    auto issue = [&](TrItem& t, int r) {
        const float* src; int ldn, K, p0, k0; bf16_t* WT; const float* ks = k_ones;
        if (r < CIU) { const int e = r >> 9, rr = r & 511, kb = rr >> 5, pb = rr & 31, p = pb * 32 + 4 * c4;
            const int pl = p & 255, bj = pl >> 7, wc = (pl >> 5) & 3, n = (pl >> 4) & 1, fq = (pl >> 2) & 3;
            const int ffc = 128 * (p >> 8) + 32 * wc + 8 * fq + 4 * n;
            src = (bj == 0 ? A.w_gate : A.w_up) + (size_t)e * 1024 * 512 + ffc; ldn = 512; WT = Wgu + (size_t)e * 1024 * 1024; K = 1024; p0 = pb * 32; k0 = kb * 64; ks = A.norm_ffn_g; }
        else { r -= CIU; const int e = r >> 8, rr = r & 255, kb = rr >> 5, pb = rr & 31, p = pb * 32 + 4 * c4;
            src = A.w_down + (size_t)e * 512 * 1024 + (p & ~255) + colmap_std(p & 255); ldn = 1024; WT = WdT + (size_t)e * 1024 * 512; K = 512; p0 = pb * 32; k0 = kb * 64; }
        tr_load(t, src, ldn, WT, K, p0, k0, lane, ks);
    };
    auto idx = [&](int j) { return lo + w0 + j * nw; };
    const int n = (hi - lo - w0 + nw - 1) / nw;
    if (n <= 0) return;
    TrItem ta, tb;
    issue(ta, idx(0));
    int j = 0;
    for (; j + 2 < n; j += 2) {
        issue(tb, idx(j + 1));
        tr_finish(ta, scr, lane);
        issue(ta, idx(j + 2));
        tr_finish(tb, scr, lane);
    }
    if (n - j == 2) { issue(tb, idx(j + 1)); tr_finish(ta, scr, lane); tr_finish(tb, scr, lane); }
    else tr_finish(ta, scr, lane);
}

#define WS_PTRS \
    size_t wsz_ = 0; asm volatile("" : "+s"(wsz_)); unsigned char* ws = A.ws + wsz_;   \
    int* cnt = (int*)(ws + WS_CTL); \
    bf16_t* WinT = (bf16_t*)(ws + WS_WIN); bf16_t* WretoT = (bf16_t*)(ws + WS_WRETO); bf16_t* WswaoT = (bf16_t*)(ws + WS_WSWAO); bf16_t* WoutT = (bf16_t*)(ws + WS_WOUT); bf16_t* WrT = (bf16_t*)(ws + WS_WR); \
    float* rcos = (float*)(ws + WS_ROT); float* rsin = rcos + SEQ * 64; \
    float* SS = (float*)(ws + WS_SS); float* RT = (float*)(ws + WS_RT); \
    bf16_t* H = (bf16_t*)(ws + WS_H); bf16_t* DR = H; bf16_t* RG = H; bf16_t* YB = H; signed char* H8 = (signed char*)(ws + WS_H); float* HS = (float*)(ws + WS_RT); float* CSC = (float*)(ws + WS_SS); unsigned char* X8 = ws + WS_QR;   float* XS = (float*)(ws + WS_CTL + CTL_XS); float* ECS = (float*)(ws + WS_CTL + CTL_ECS); \
    bf16_t* Qr = (bf16_t*)(ws + WS_QR); bf16_t* Kr = (bf16_t*)(ws + WS_KR); bf16_t* T = Qr; bf16_t* Wgu = (bf16_t*)(ws + WS_WGU); \
    bf16_t* KdT = (bf16_t*)(ws + WS_KDT); bf16_t* WdT = (bf16_t*)(ws + WS_WDT); \
    bf16_t* VT = (bf16_t*)(ws + WS_VT); bf16_t* MG = VT; \
    bf16_t* Gs = (bf16_t*)(ws + WS_GS); bf16_t* XG2 = Gs; \
    bf16_t* SQ = (bf16_t*)(ws + WS_SQ); float* LOG = (float*)(ws + WS_SK); \
    bf16_t* SK = (bf16_t*)(ws + WS_SK); bf16_t* SVT = (bf16_t*)(ws + WS_SVT); \
    bf16_t* RP = (bf16_t*)((unsigned char*)A.out + 64 * MiB); bf16_t* HM = (bf16_t*)(ws + WS_KDT); \
    bf16_t* SWo = (bf16_t*)(ws + WS_SW); \
    int* LTOK = (int*)(ws + WS_LTOK); float* LW = (float*)(ws + WS_LW); f32x2* LRX = (f32x2*)(ws + WS_H);   \
    unsigned char* GA = (unsigned char*)A.out; unsigned char* GB = GA + (size_t)NTOK * 1024;

__global__ void __launch_bounds__(512, 2) hyb_fwd(Args A) {
    extern __shared__ __attribute__((aligned(16))) unsigned char lds_raw[];
    LAS unsigned char* lds = (LAS unsigned char*)lds_raw;
    cg::grid_group grid = cg::this_grid();
    const int tid = threadIdx.x, lane = tid & 63, wave = __builtin_amdgcn_readfirstlane(tid >> 6);
    const int G = gridDim.x, bx = blockIdx.x;
    const int gw = bx * 8 + wave, NGW = G * 8;
    const int r32 = lane & 31, hi = lane >> 5;
    LAS int* tab = (LAS int*)(lds + LDS_TAB);
    volatile LAS unsigned* SV = (volatile LAS unsigned*)(lds + LDS_TAB + 3072);
    volatile LAS unsigned* MISC = (volatile LAS unsigned*)(lds + LDS_TAB + 2048);
    if (tid < 2) MISC[tid] = 0u;
    __syncthreads();
    const XcdBarrier xbar = xcd_barrier_post((unsigned*)(A.ws + WS_CTL) + 1024, MISC);
#define GSYNC() xcd_barrier(xbar)
#define GSYNC_QW(k) do { xcd_arrive(xbar, SV); quant_wgu(A.ws, lane, (k) * 8192, ((k) + 1) * 8192, gw, NGW); xcd_wait(xbar, SV); } while (0)
    volatile LAS unsigned long long* TS = (volatile LAS unsigned long long*)(lds + LDS_TAB + 4096);
    int n_ts = 0;
#define STAMP() do { if (PROBE_A >= 0) { if (bx == 0 && tid == 0) TS[n_ts] = __builtin_amdgcn_s_memrealtime(); ++n_ts; } } while (0)
    STAMP();

    if constexpr ((PHMASK >> 0) & 1) {
        WS_PTRS;
        LAS float* scr = (LAS float*)(lds + wave * 16384);
        win_colmax(A, ws, lane, gw, NGW);
        xcd_arrive(xbar, SV);
        for (int m = gw; m < NTOK; m += 2 * NGW) {
            const int m2 = m + NGW;
            const bool h2 = m2 < NTOK;
            const f32x4* xr = (const f32x4*)(A.x + (size_t)m * DM) + lane;
            const f32x4* xr2 = (const f32x4*)(A.x + (size_t)(h2 ? m2 : m) * DM) + lane;
            f32x4 v[4], v2[4]; float s = 0.f, s2 = 0.f;
#pragma unroll
            for (int j = 0; j < 4; ++j) { v[j] = xr[64 * j]; v2[j] = xr2[64 * j]; }
#pragma unroll
            for (int j = 0; j < 4; ++j) { s += (v[j][0] * v[j][0] + v[j][1] * v[j][1]) + (v[j][2] * v[j][2] + v[j][3] * v[j][3]); s2 += (v2[j][0] * v2[j][0] + v2[j][1] * v2[j][1]) + (v2[j][2] * v2[j][2] + v2[j][3] * v2[j][3]); }
            const float r = __builtin_amdgcn_rsqf(wave_sum(s) * (1.0f / DM) + EPS), r2 = __builtin_amdgcn_rsqf(wave_sum(s2) * (1.0f / DM) + EPS);
            float am = 0.f, am2 = 0.f;
#pragma unroll
            for (int j = 0; j < 4; ++j) { const f32x4 g = ((const f32x4*)A.norm_mix_g)[lane + 64 * j]; v[j] = v[j] * r * g; v2[j] = v2[j] * r2 * g;
                am = fmaxf(fmaxf(am, fmaxf(fabsf(v[j][0]), fabsf(v[j][1]))), fmaxf(fabsf(v[j][2]), fabsf(v[j][3])));
                am2 = fmaxf(fmaxf(am2, fmaxf(fabsf(v2[j][0]), fabsf(v2[j][1]))), fmaxf(fabsf(v2[j][2]), fabsf(v2[j][3]))); }
            am = fmaxf(wave_max(am), 1e-30f); am2 = fmaxf(wave_max(am2), 1e-30f);
            const float qs = 127.0f * __builtin_amdgcn_rcpf(am), qs2 = 127.0f * __builtin_amdgcn_rcpf(am2);
            unsigned* o8 = (unsigned*)(H8 + (size_t)m * DM) + lane; unsigned* o82 = (unsigned*)(H8 + (size_t)m2 * DM) + lane;
#pragma unroll
            for (int j = 0; j < 4; ++j) {
                unsigned w = 0, w2 = 0;
#pragma unroll
                for (int b = 0; b < 4; ++b) { const int c = (int)__builtin_rintf(fminf(fmaxf(v[j][b] * qs, -127.0f), 127.0f)), c2 = (int)__builtin_rintf(fminf(fmaxf(v2[j][b] * qs2, -127.0f), 127.0f));
                    w |= ((unsigned)c & 255u) << (8 * b); w2 |= ((unsigned)c2 & 255u) << (8 * b); }
                o8[64 * j] = w; if (h2) o82[64 * j] = w2;
            }
            if (lane == 0) { HS[m] = am * (1.0f / 127.0f); if (h2) HS[m2] = am2 * (1.0f / 127.0f); }
        }
        for (int e = bx * 512 + tid; e < SEQ * 64; e += G * 512) {
            const int pos = e >> 6, i = e & 63;
            double inv = 1.0; for (int k = 0; k < i; ++k) inv *= 0.8659643233600653;
            double s, c; sincos_d((double)pos * inv, s, c);
            rcos[e] = (float)c; rsin[e] = (float)s;
        }
        xcd_wait(xbar, SV);
        conv_win_i8(A, ws, scr, lane, gw, NGW);
        conv_items(A, ws, scr, lane, CI0, CNS, gw, NGW);
        xcd_arrive(xbar, SV);
        conv_expert_items(A, ws, scr, lane, 0, CEXP0, gw, NGW);
        xcd_wait(xbar, SV);
    }
    if (__builtin_expect(A.out == nullptr, 0)) grid.sync();
    STAMP();

    if constexpr ((PHMASK >> 1) & 1) {
        WS_PTRS;
        pg8::DenseOrder S; S.init(NTOK, INW, 512, G, bx, WinT, 0, WGM_P1);
        EpiProj E{Qr, Kr, KdT, VT, Gs, SQ, SK, SVT, GA, GB, rcos, rsin, A.q_norm_g, A.k_norm_g, HS, CSC};
        pg8::gemm_phase<EpiProj, pg8::DenseOrder, 0, true>(lds, (const char*)H8, 512, S, E);
        if ((ABL & 16) ? (bx < 128) : (bx >= 128)) {
            __syncthreads();
            conv_expert_items(A, ws, (LAS float*)(lds + wave * 16384), lane, CEXP0, CEXP0 + CEXP1, ((bx & 127)) * 8 + wave, 128 * 8);
        }
    }
    GSYNC_QW(0); STAMP();

    if constexpr ((PHMASK >> 2) & 1) {
        WS_PTRS;
        {
            int item = bx;
            if (item < 1024) { const int bh = item >> 6, c = item & 63;
                stage_tile<256>(lds, 0, (const char*)(VT + (size_t)bh * 256 * SEQ + c * 128), (size_t)SEQ * 2, 256, wave, lane);
                stage_tile<256>(lds, 65536, (const char*)(KdT + (size_t)bh * 128 * SEQ + c * 128), (size_t)SEQ * 2, 128, wave, lane); }
            for (; item < 1024; item += G) {
                asm volatile("s_waitcnt vmcnt(0)" ::: "memory"); __syncthreads();
                f32x16 acc[4];
#pragma unroll
                for (int d = 0; d < 4; ++d)
#pragma unroll
                    for (int r = 0; r < 16; ++r) acc[d][r] = 0.f;
#pragma unroll
                for (int s = 0; s < 8; ++s) {
                    const bf16x8 a = LDS_V16(swz<256>(32 * wave + r32, 2 * s + hi));
#pragma unroll
                    for (int d = 0; d < 4; ++d) { const bf16x8 b = LDS_V16(65536 + swz<256>(32 * d + r32, 2 * s + hi)); acc[d] = MFMA32(a, b, acc[d]); }
                }
                __syncthreads();
                const int nx = item + G;
                if (nx < 1024) { const int bh = nx >> 6, c = nx & 63;
                    stage_tile<256>(lds, 0, (const char*)(VT + (size_t)bh * 256 * SEQ + c * 128), (size_t)SEQ * 2, 256, wave, lane);
                    stage_tile<256>(lds, 65536, (const char*)(KdT + (size_t)bh * 128 * SEQ + c * 128), (size_t)SEQ * 2, 128, wave, lane); }
                bf16_t* dr = DR + (size_t)item * 32768;
#pragma unroll
                for (int d = 0; d < 4; ++d)
#pragma unroll
                    for (int r = 0; r < 16; ++r) dr[(32 * wave + crow(r, hi)) * 128 + d * 32 + r32] = f2bf(acc[d][r]);
            }
            asm volatile("s_waitcnt vmcnt(0)" ::: "memory"); __syncthreads();
        }
        xcd_arrive(xbar, SV);
        {
            auto stage_swa = [&](int it) {
                const int n = it & 63, kvh = (it >> 6) & 1, b = it >> 7;
                stage_tile<512>(lds, 0, (const char*)(SQ + (size_t)(b * SEQ + n * 128) * 512 + kvh * 256), 1024, 128, wave, lane);
                const int k0 = n * 128 - 128;
                stage_tile<128>(lds, 65536, (const char*)(SK + ((size_t)b * SEQ + k0) * 128 + kvh * 64), 256, 256, wave, lane);
                stage_tile<512>(lds, 98304, (const char*)(SVT + (size_t)((b * 2 + kvh) * 64) * SEQ + k0), (size_t)SEQ * 2, 64, wave, lane);
            };
            int it = bx;
            if (it < 512) stage_swa(it);
            for (; it < 512; it += G) {
                const int n = it & 63, kvh = (it >> 6) & 1, b = it >> 7;
                asm volatile("s_waitcnt vmcnt(0)" ::: "memory"); __syncthreads();
                const int g = wave & 3, head = kvh * 4 + g;
                const float sink = A.sinks[head];
                for (int ib = 2 * (wave >> 2); ib < 2 * (wave >> 2) + 2; ++ib) {
                    const int tokq = b * SEQ + n * 128 + ib * 32 + r32;
                    bf16x8 qf[4];
#pragma unroll
                    for (int s = 0; s < 4; ++s) qf[s] = LDS_V16(swz<512>(ib * 32 + r32, g * 8 + 2 * s + hi));
                    f32x16 X[5];
                    float mx = sink;
#pragma unroll
                    for (int kb = 0; kb < 5; ++kb) {
                        const bool live = (n > 0) || (ib + kb >= 4);
#pragma unroll
                        for (int r = 0; r < 16; ++r) X[kb][r] = 0.f;
                        if (live) {
#pragma unroll
                            for (int s = 0; s < 4; ++s) { const bf16x8 a = LDS_V16(65536 + swz<128>((ib + kb) * 32 + r32, 2 * s + hi)); X[kb] = MFMA32(a, qf[s], X[kb]); }
                        }
#pragma unroll
                        for (int r = 0; r < 16; ++r) {
                            const int j = crow(r, hi);
                            const bool valid = live && (kb == 0 ? (j > r32) : (kb == 4 ? (j <= r32) : true));
                            X[kb][r] = valid ? X[kb][r] : -INFINITY;
                            mx = fmaxf(mx, X[kb][r]);
                        }
                    }
                    mx = fmaxf(mx, __shfl_xor(mx, 32));
                    float den = 0.f;
#pragma unroll
                    for (int kb = 0; kb < 5; ++kb)
#pragma unroll
                        for (int r = 0; r < 16; ++r) { const float p = __expf(X[kb][r] - mx); X[kb][r] = p; den += p; }
                    den += __shfl_xor(den, 32);
                    den += __expf(sink - mx);
                    const float rden = __builtin_amdgcn_rcpf(den);
                    f32x16 o[2];
#pragma unroll
                    for (int d = 0; d < 2; ++d)
#pragma unroll
                        for (int r = 0; r < 16; ++r) o[d][r] = 0.f;
#pragma unroll
                    for (int kb = 0; kb < 5; ++kb) {
                        const bool live = (n > 0) || (ib + kb >= 4);
                        if (live) {
#pragma unroll
                            for (int s2 = 0; s2 < 2; ++s2) {
                                const bf16x8 pb = pack8(X[kb], s2);
#pragma unroll
                                for (int d = 0; d < 2; ++d) {
                                    const int ch = 4 * (ib + kb) + 2 * s2;
                                    const u32x2 lo = LDS_V8(98304 + swz<512>(d * 32 + r32, ch) + 8 * hi), hh = LDS_V8(98304 + swz<512>(d * 32 + r32, ch + 1) + 8 * hi);
                                    u32x4 av; av.x = lo.x; av.y = lo.y; av.z = hh.x; av.w = hh.y;
                                    o[d] = MFMA32(__builtin_bit_cast(bf16x8, av), pb, o[d]);
                                }
                            }
                        }
                    }
#pragma unroll
                    for (int d = 0; d < 2; ++d)
#pragma unroll
                        for (int q = 0; q < 4; ++q) {
                            u32x2 w; w.x = pk2(o[d][4 * q] * rden, o[d][4 * q + 1] * rden); w.y = pk2(o[d][4 * q + 2] * rden, o[d][4 * q + 3] * rden);
                            *(u32x2*)(SWo + (size_t)tokq * 512 + head * 64 + d * 32 + 8 * q + 4 * hi) = w;
                        }
                }
                __syncthreads();
                if (it + G < 512) stage_swa(it + G);
            }
            asm volatile("s_waitcnt vmcnt(0)" ::: "memory");
        }
    }
    xcd_wait(xbar, SV); STAMP();

    if constexpr ((PHMASK >> 3) & 1) {
        WS_PTRS;
        for (int gi = bx * 256 + tid; tid < 256 && gi < 16 * 4096; gi += G * 256) {
            const int bh = gi >> 12, e8 = gi & 4095, h = bh & 3;
            const float dec = __builtin_amdgcn_exp2f(128.0f * lg2gamma(h));
            float r[8];
#pragma unroll
            for (int j = 0; j < 8; ++j) r[j] = 0.f;
            const size_t base = (size_t)bh * 64 * 32768 + (size_t)e8 * 8;
#pragma unroll 8
            for (int c = 0; c < 64; ++c) {
                const u32x4 d = *(const u32x4*)(DR + base + (size_t)c * 32768);
                u32x4 w; w.x = pk2(r[0], r[1]); w.y = pk2(r[2], r[3]); w.z = pk2(r[4], r[5]); w.w = pk2(r[6], r[7]);
                *(u32x4*)(RP + base + (size_t)c * 32768) = w;
                r[0] = r[0] * dec + bflo(d.x); r[1] = r[1] * dec + bfhi(d.x); r[2] = r[2] * dec + bflo(d.y); r[3] = r[3] * dec + bfhi(d.y);
                r[4] = r[4] * dec + bflo(d.z); r[5] = r[5] * dec + bfhi(d.z); r[6] = r[6] * dec + bflo(d.w); r[7] = r[7] * dec + bfhi(d.w);
            }
        }
    }
    xcd_arrive(xbar, SV);
    conv_expert_items(A, A.ws, (LAS float*)(lds + wave * 16384), lane, CEXP0 + CEXP1, CIU + CID, gw, NGW);
    xcd_wait(xbar, SV); STAMP();

    if constexpr ((PHMASK >> 4) & 1) {
        WS_PTRS;
        LAS float* xs = (LAS float*)(lds + LDS_TAB + 12288);
        auto stage_qk = [&](int it) { const int bh = it >> 6, c = it & 63, b = bh >> 2, h = bh & 3; const size_t t0 = (size_t)b * SEQ + c * 128;
            stage_tile<256>(lds, 0, (const char*)(Qr + t0 * 512 + h * 128), 1024, 128, wave, lane);
            stage_tile<256>(lds, 32768, (const char*)(Kr + t0 * 512 + h * 128), 1024, 128, wave, lane); };
        auto stage_rp = [&](int it) { stage_tile<256>(lds, 65536, (const char*)(RP + (size_t)it * 32768), 256, 256, wave, lane); };
        auto stage_vt = [&](int it) { const int bh = it >> 6, c = it & 63; stage_tile<256>(lds, 65536, (const char*)(VT + (size_t)bh * 256 * SEQ + c * 128), (size_t)SEQ * 2, 256, wave, lane); };
        int item = bx;
        if (item < 1024) { stage_qk(item); stage_rp(item); }
        for (; item < 1024; item += G) {
            const int bh = item >> 6, c = item & 63, b = bh >> 2, h = bh & 3, ib = wave & 3, dh = wave >> 2;
            const float lg = lg2gamma(h);
            int r32o = r32, hio = hi; asm volatile("" : "+v"(r32o), "+v"(hio));
            const int il = ib * 32 + r32o;
            const int xk = r32o & 15;
            const int nx = item + G;
            asm volatile("s_waitcnt vmcnt(0)" ::: "memory"); __syncthreads();
            bf16x8 qf[8];
#pragma unroll
            for (int s = 0; s < 8; ++s) qf[s] = LDS_V16(il * 256 + (((2 * s + hio) ^ xk) << 4));
            f32x16 acc[4];
#pragma unroll
            for (int d = 0; d < 4; ++d)
#pragma unroll
                for (int r = 0; r < 16; ++r) acc[d][r] = 0.f;
            { const int rb = 65536 + (dh * 128 + r32o) * 256;
#pragma unroll
              for (int s = 0; s < 8; ++s) { const int co = ((2 * s + hio) ^ xk) << 4;
#pragma unroll
                for (int d = 0; d < 4; ++d) { const bf16x8 a = LDS_V16(rb + d * 8192 + co); acc[d] = MFMA32(a, qf[s], acc[d]); } } }
            const float fc = __builtin_amdgcn_exp2f((float)(il + 1) * lg);
#pragma unroll
            for (int d = 0; d < 4; ++d)
#pragma unroll
                for (int r = 0; r < 16; ++r) acc[d][r] *= fc;
            __syncthreads();
            stage_vt(item);
            bf16x8 pf[4][2];
#pragma unroll
            for (int jb = 0; jb < 4; ++jb) {
                if (jb <= ib) {
                    f32x16 X;
#pragma unroll
                    for (int r = 0; r < 16; ++r) X[r] = 0.f;
                    const int kbs = 32768 + (jb * 32 + r32o) * 256;
#pragma unroll
                    for (int s = 0; s < 8; ++s) { const bf16x8 a = LDS_V16(kbs + (((2 * s + hio) ^ xk) << 4)); X = MFMA32(a, qf[s], X); }
#pragma unroll
                    for (int r = 0; r < 16; ++r) { const int dd = il - (jb * 32 + crow(r, hio)); X[r] = dd >= 0 ? X[r] * __builtin_amdgcn_exp2f((float)dd * lg) : 0.f; }
                    pf[jb][0] = pack8(X, 0); pf[jb][1] = pack8(X, 1);
                } else { pf[jb][0] = (bf16x8){0, 0, 0, 0, 0, 0, 0, 0}; pf[jb][1] = pf[jb][0]; }
            }
            asm volatile("s_waitcnt vmcnt(0)" ::: "memory"); __syncthreads();
            if (nx < 1024) stage_qk(nx);
            const int tok = b * SEQ + c * 128 + il;
            u32x4 gsw[4][2];
#pragma unroll
            for (int d = 0; d < 4; ++d)
#pragma unroll
                for (int k = 0; k < 2; ++k) gsw[d][k] = *(const u32x4*)(Gs + (size_t)tok * 1024 + h * 256 + dh * 128 + d * 32 + 16 * k + 8 * hio);
            { const int vb = 65536 + (dh * 128 + r32o) * 256 + 8 * hio;
#pragma unroll
              for (int jb = 0; jb < 4; ++jb) {
                if (jb <= ib) {
#pragma unroll
                    for (int s2 = 0; s2 < 2; ++s2) { const int c0 = ((4 * jb + 2 * s2) ^ xk) << 4, c1 = ((4 * jb + 2 * s2 + 1) ^ xk) << 4;
#pragma unroll
                        for (int d = 0; d < 4; ++d) {
                            const u32x2 lo = LDS_V8(vb + d * 8192 + c0), hh = LDS_V8(vb + d * 8192 + c1);
                            u32x4 av; av.x = lo.x; av.y = lo.y; av.z = hh.x; av.w = hh.y;
                            acc[d] = MFMA32(__builtin_bit_cast(bf16x8, av), pf[jb][s2], acc[d]);
                        } }
                }
              } }
            float sm = 0.f, sq = 0.f;
#pragma unroll
            for (int d = 0; d < 4; ++d)
#pragma unroll
                for (int r = 0; r < 16; ++r) { sm += acc[d][r]; sq += acc[d][r] * acc[d][r]; }
            sm += __shfl_xor(sm, 32); sq += __shfl_xor(sq, 32);
            if (hio == 0) { xs[((dh * 4 + ib) * 32 + r32o) * 2] = sm; xs[((dh * 4 + ib) * 32 + r32o) * 2 + 1] = sq; }
            __syncthreads();
            if (nx < 1024) stage_rp(nx);
            sm += xs[(((dh ^ 1) * 4 + ib) * 32 + r32o) * 2]; sq += xs[(((dh ^ 1) * 4 + ib) * 32 + r32o) * 2 + 1];
            const float mu = sm * (1.0f / 256.0f);
            const float var = fmaxf(sq * (1.0f / 256.0f) - mu * mu, 0.f);
            const float rstd = __builtin_amdgcn_rsqf(var + EPS);
#pragma unroll
            for (int d = 0; d < 4; ++d)
#pragma unroll
                for (int k = 0; k < 2; ++k) {
                    u32x4 g = gsw[d][k];
                    { auto r0 = __builtin_amdgcn_permlane32_swap(g.x, g.z, false, false); g.x = r0[0]; g.z = r0[1]; auto r1 = __builtin_amdgcn_permlane32_swap(g.y, g.w, false, false); g.y = r1[0]; g.w = r1[1]; }
                    u32x2 w[2];
#pragma unroll
                    for (int e = 0; e < 2; ++e) {
                        const int q = 2 * k + e, dv = dh * 128 + d * 32 + 8 * q + 4 * hio;
                        const f32x4 gn = *(const f32x4*)(A.ret_gn_g + h * 256 + dv);
                        const unsigned g0 = e ? g.z : g.x, g1 = e ? g.w : g.y;
                        const float y0 = (acc[d][4 * q] - mu) * rstd * gn[0] * bflo(g0), y1 = (acc[d][4 * q + 1] - mu) * rstd * gn[1] * bfhi(g0);
                        const float y2 = (acc[d][4 * q + 2] - mu) * rstd * gn[2] * bflo(g1), y3 = (acc[d][4 * q + 3] - mu) * rstd * gn[3] * bfhi(g1);
                        w[e].x = pk2(y0, y1); w[e].y = pk2(y2, y3);
                    }
                    { auto r0 = __builtin_amdgcn_permlane32_swap(w[0].x, w[1].x, false, false); w[0].x = r0[0]; w[1].x = r0[1]; auto r1 = __builtin_amdgcn_permlane32_swap(w[0].y, w[1].y, false, false); w[0].y = r1[0]; w[1].y = r1[1]; }
                    *(u32x4*)(RG + (size_t)tok * 1024 + h * 256 + dh * 128 + d * 32 + 16 * k + 8 * hio) = (u32x4){w[0].x, w[0].y, w[1].x, w[1].y};
                }
        }
        asm volatile("s_waitcnt vmcnt(0)" ::: "memory"); __syncthreads();
    }
    GSYNC_QW(1); STAMP();

    if constexpr ((PHMASK >> 5) & 1) {
        WS_PTRS;
        pg8::DenseOrder S; S.init(NTOK, 1024, 1536, G, bx, WretoT, 1024, WGM_P5);
        EpiMerge E{GA, GB, MG};
        pg8::gemm_phase<EpiMerge, pg8::DenseOrder, 16>(lds, (const char*)RG, 1536, S, E, (const char*)SWo);
        if (ABL & 65536) { __syncthreads(); pg8::gemm_phase<EpiMerge, pg8::DenseOrder, 16>(lds, (const char*)RG, 1536, S, E, (const char*)SWo); }
    }
    GSYNC_QW(2); STAMP();

    if constexpr ((PHMASK >> 6) & 1) {
        WS_PTRS;
        pg8::DenseOrder S; S.init(NTOK, 1024, 1024, G, bx, WoutT, 0, WGM_P6);
        EpiOut E{A.x, XG2, SS};
        pg8::gemm_phase(lds, (const char*)MG, 1024, S, E);
    }
    GSYNC_QW(3); STAMP();

    if constexpr ((PHMASK >> 7) & 1) {
        WS_PTRS;
        typedef float f32x4v __attribute__((ext_vector_type(4)));
        LAS float* LG = (LAS float*)(lds + 98304);
        LAS int* lcnt = (LAS int*)(lds + LDS_TAB + 8192);
        if (tid < 64) lcnt[tid] = 0;
        {
            const int fr = lane & 15, fq = lane >> 4;
            const int row0 = bx * 128 + wave * 16;
            typedef __attribute__((address_space(1))) const bf16x8 gbf16x8;
            for (int i = wave; i < 96; i += 8) {
                const int r = i >> 1, half = i & 1, pr = r < 32 ? r : 96 + r, slot = half * 64 + lane;
                __builtin_amdgcn_global_load_lds((const unsigned*)(WrT + (size_t)pr * 1024 + ((slot ^ (r & 15)) << 3)), (LAS unsigned*)(lds + r * 2048 + half * 1024), 16, 0, 0);
            }
            gbf16x8* ap = (gbf16x8*)(XG2 + (size_t)(row0 + fr) * 1024 + 8 * fq);
            bf16x8 av[32];
#pragma unroll
            for (int kk = 0; kk < 32; ++kk) av[kk] = ap[kk * 4];
            asm volatile("s_waitcnt vmcnt(0)" ::: "memory"); __syncthreads();
            float am = 0.f;
#pragma unroll
            for (int kk = 0; kk < 32; ++kk) { const u32x4 w = __builtin_bit_cast(u32x4, av[kk]);
                const unsigned m01 = (w.x & 0x7fff7fffu), m23 = (w.y & 0x7fff7fffu), m45 = (w.z & 0x7fff7fffu), m67 = (w.w & 0x7fff7fffu);
                am = fmaxf(am, fmaxf(fmaxf(bflo(m01), bfhi(m01)), fmaxf(bflo(m23), bfhi(m23))));
                am = fmaxf(am, fmaxf(fmaxf(bflo(m45), bfhi(m45)), fmaxf(bflo(m67), bfhi(m67)))); }
            am = fmaxf(am, __shfl_xor(am, 16)); am = fmaxf(am, __shfl_xor(am, 32)); am = fmaxf(am, 1e-30f);
            float qs = 127.0f * __builtin_amdgcn_rcpf(am);
            unsigned char* xo = X8 + (size_t)(row0 + fr) * 2048 + 8 * fq;
            if (fq == 0) ((LAS float*)(lds + 118784))[wave * 16 + fr] = am * (1.0f / 127.0f);
            f32x4v a0 = {0.f, 0.f, 0.f, 0.f}, a1 = a0, a2 = a0;
            const int xk = fr;
#pragma unroll
            for (int kk = 0; kk < ((ABL & 64) ? 0 : 32); ++kk) {
                const int co = ((4 * kk + fq) ^ xk) << 4;
                const bf16x8 b0 = LDS_V16(fr * 2048 + co), b1 = LDS_V16((16 + fr) * 2048 + co), b2 = LDS_V16((32 + fr) * 2048 + co);
                a0 = __builtin_amdgcn_mfma_f32_16x16x32_bf16(av[kk], b0, a0, 0, 0, 0);
                a1 = __builtin_amdgcn_mfma_f32_16x16x32_bf16(av[kk], b1, a1, 0, 0, 0);
                a2 = __builtin_amdgcn_mfma_f32_16x16x32_bf16(av[kk], b2, a2, 0, 0, 0);
                asm volatile("" : "+v"(qs));
                { const u32x4 w = __builtin_bit_cast(u32x4, av[kk]);
                  unsigned ox = 0u, oy = 0u;
                  ox = __builtin_amdgcn_cvt_pk_u8_f32(__builtin_fmaf(bflo(w.x), qs, 128.0f), 0, ox); ox = __builtin_amdgcn_cvt_pk_u8_f32(__builtin_fmaf(bfhi(w.x), qs, 128.0f), 1, ox);
                  ox = __builtin_amdgcn_cvt_pk_u8_f32(__builtin_fmaf(bflo(w.y), qs, 128.0f), 2, ox); ox = __builtin_amdgcn_cvt_pk_u8_f32(__builtin_fmaf(bfhi(w.y), qs, 128.0f), 3, ox);
                  oy = __builtin_amdgcn_cvt_pk_u8_f32(__builtin_fmaf(bflo(w.z), qs, 128.0f), 0, oy); oy = __builtin_amdgcn_cvt_pk_u8_f32(__builtin_fmaf(bfhi(w.z), qs, 128.0f), 1, oy);
                  oy = __builtin_amdgcn_cvt_pk_u8_f32(__builtin_fmaf(bflo(w.w), qs, 128.0f), 2, oy); oy = __builtin_amdgcn_cvt_pk_u8_f32(__builtin_fmaf(bfhi(w.w), qs, 128.0f), 3, oy);
                  u32x2 o; o.x = ox ^ 0x80808080u; o.y = oy ^ 0x80808080u;
                  *(u32x2*)(xo + 32 * kk) = o; }
            }
            const int L0 = colmap_std(fr), L1 = colmap_std(16 + fr), L2 = colmap_std(128 + fr);
#pragma unroll
            for (int r = 0; r < 4; ++r) {
                LAS float* lr = LG + (wave * 16 + 4 * fq + r) * 40;
                if (L0 < 36) lr[L0] = a0[r];
                if (L1 < 36) lr[L1] = a1[r];
                if (L2 < 36) lr[L2] = a2[r];
            }
        }
        __syncthreads();
        int t = 0, ga = 0, gb = 0, la = 0, lb = 0; float w0 = 0.f, w1 = 0.f, rr_ = 0.f, xs_ = 0.f;
        if (tid < 128 && !(ABL & 128)) {
            t = bx * 128 + tid;
            const LAS float* lg = LG + tid * 40;
            float ss = 0.f;
#pragma unroll
            for (int k = 0; k < 4; ++k) { const f32x4 v = *(const f32x4*)(SS + (size_t)t * 16 + 4 * k); ss += (v[0] + v[1]) + (v[2] + v[3]); }
            const float r = __builtin_amdgcn_rsqf(ss * (1.0f / DM) + EPS);
            RT[t] = r; rr_ = r; xs_ = ((const LAS float*)(lds + 118784))[tid];
            float gl[4];
#pragma unroll
            for (int k = 0; k < 4; ++k) gl[k] = lg[k] * r + A.b_rg[k];
            int gi = 0; float gm = gl[0];
#pragma unroll
            for (int k = 1; k < 4; ++k) if (gl[k] > gm) { gm = gl[k]; gi = k; }
            float gs = 0.f;
#pragma unroll
            for (int k = 0; k < 4; ++k) gs += __expf(gl[k] - gm);
            const float gprob = __builtin_amdgcn_rcpf(gs);
            float el[8];
#pragma unroll
            for (int k = 0; k < 8; ++k) el[k] = lg[4 + gi * 8 + k] * r + A.b_re[gi * 8 + k];
            int e0 = 0; float m0 = el[0];
#pragma unroll
            for (int k = 1; k < 8; ++k) if (el[k] > m0) { m0 = el[k]; e0 = k; }
            int e1 = 0; float m1 = -INFINITY;
#pragma unroll
            for (int k = 0; k < 8; ++k) if (k != e0 && el[k] > m1) { m1 = el[k]; e1 = k; }
            const float x1 = __expf(m1 - m0);
            { const float r1_ = gprob * __builtin_amdgcn_rcpf(1.0f + x1); w0 = r1_; w1 = r1_ * x1; }
            ga = gi * 8 + e0; gb = 32 + gi * 8 + e1;
            la = __hip_atomic_fetch_add(lcnt + ga, 1, __ATOMIC_RELAXED, __HIP_MEMORY_SCOPE_WORKGROUP);
            lb = __hip_atomic_fetch_add(lcnt + gb, 1, __ATOMIC_RELAXED, __HIP_MEMORY_SCOPE_WORKGROUP);
        }
        __syncthreads();
        if (tid < 64) lcnt[64 + tid] = lcnt[tid] ? atomicAdd(cnt + tid, lcnt[tid]) : 0;
        __syncthreads();
        if (tid < 128) {
            const int ra = lcnt[64 + ga] + la, rb = lcnt[64 + gb] + lb;
            LTOK[(size_t)ga * LCAP + ra] = t; LW[(size_t)ga * LCAP + ra] = w0; LRX[(size_t)ga * LCAP + ra] = (f32x2){rr_, xs_}; LRX[(size_t)gb * LCAP + rb] = (f32x2){rr_, xs_};
            LTOK[(size_t)gb * LCAP + rb] = t; LW[(size_t)gb * LCAP + rb] = w1;
        }
        __syncthreads();
    }
    GSYNC(); STAMP();

    if (tid == 0) {
        WS_PTRS;
        int tp = 0;
        for (int g = 0; g < 64; ++g) { const int c = cnt[g]; tab[g] = c; tab[64 + g] = tp; tab[192 + g] = tp * 256; tp += (c + 255) >> 8; }
        tab[128] = tp;
    }
    __syncthreads();

    if constexpr ((PHMASK >> 8) & 1) {
        WS_PTRS;
        pg8::GroupOrder S; S.init(tab, 0, 64, 1024, G, bx, Wgu, (size_t)1024 * 1024 * 2, LTOK, true);
        EpiUp E{HM, tab, LRX, ECS};
        pg8::gemm_phase<EpiUp, pg8::GroupOrder, 0, true, 8>(lds, (const char*)X8, 1024, S, E);
    }
    GSYNC(); STAMP();
    if constexpr ((PHMASK >> 9) & 1) {
        WS_PTRS;
        pg8::GroupOrder S; S.init(tab, 0, 32, 512, G, bx, WdT, (size_t)1024 * 512 * 2, LTOK, false);
        EpiDown<0> E{XG2, YB, A.out, tab, LTOK, LW, &xbar, SV};
        pg8::gemm_phase(lds, (const char*)HM, 512, S, E);
    }
    if (tid == 0) SV[3] = 0u;
    xcd_arrive(xbar, SV); STAMP();
    if constexpr ((PHMASK >> 10) & 1) {
        WS_PTRS;
        pg8::GroupOrder S; S.init(tab, 32, 32, 512, G, G - 1 - bx, WdT, (size_t)1024 * 512 * 2, LTOK, false);
        EpiDown<1> E{YB, YB, A.out, tab, LTOK, LW, &xbar, SV};
        pg8::gemm_phase(lds, (const char*)HM, 512, S, E);
    }
    if (SV[3] == 0u) xcd_wait(xbar, SV);
    if (PROBE_A >= 0) {
        GSYNC(); STAMP();
        float* pr = (float*)(A.ws + WS_CTL) + 8192;
        if (bx == 0 && tid == 0) {
            const float da = PROBE_A == 50 ? (float)(TS[n_ts - 1] - TS[0]) * 0.001f : (float)(TS[PROBE_A + 1] - TS[PROBE_A]) * 0.01f;
            const float db = PROBE_B == 99 ? 100.0f : (float)(TS[(PROBE_B < 0 ? 0 : PROBE_B) + 1] - TS[PROBE_B < 0 ? 0 : PROBE_B]) * 0.01f;
            __hip_atomic_store(pr, PROBE_BASE > 0 ? da * (float)PROBE_BASE : da * 100.0f, __ATOMIC_RELAXED, __HIP_MEMORY_SCOPE_AGENT); __hip_atomic_store(pr + 1, db * 10.0f, __ATOMIC_RELAXED, __HIP_MEMORY_SCOPE_AGENT);
        }
        GSYNC();
        const float v1 = __hip_atomic_load(pr, __ATOMIC_RELAXED, __HIP_MEMORY_SCOPE_AGENT), v2 = __hip_atomic_load(pr + 1, __ATOMIC_RELAXED, __HIP_MEMORY_SCOPE_AGENT);
        for (size_t e = (size_t)bx * 512 + tid; e < (size_t)NTOK * DM; e += (size_t)G * 512) A.out[e] = e == 0 ? v1 : v2;
    }
}

extern "C" void kernel_launch(void* const* d_in, const int* in_sizes, int n_in, void* d_out, int out_size, void* d_ws, size_t ws_size, hipStream_t stream) {
    static int grid = 0;
    if (grid == 0) {
        if (n_in != 18 || out_size != NTOK * DM || ws_size < WS_END) { fprintf(stderr, "kernel_launch: unexpected shapes (n_in %d out %d ws %zu)\n", n_in, out_size, ws_size); grid = -1; return; }
        int dev = 0, cus = 0, per_cu = 0;
        hipGetDevice(&dev);
        hipDeviceGetAttribute(&cus, hipDeviceAttributeMultiprocessorCount, dev);
        hipFuncSetAttribute((const void*)hyb_fwd, hipFuncAttributeMaxDynamicSharedMemorySize, LDS_BYTES);
        hipOccupancyMaxActiveBlocksPerMultiprocessor(&per_cu, (const void*)hyb_fwd, 512, LDS_BYTES);
        (void)hipGetLastError();
        if (per_cu < 1) { fprintf(stderr, "kernel_launch: occupancy query says %d blocks per CU\n", per_cu); per_cu = 1; }
        grid = cus;
    }
    if (grid < 0) return;
    hipMemsetAsync((char*)d_ws + WS_CTL, 0, 65536, stream);
    Args a{};
    a.x = (const float*)d_in[0]; a.norm_mix_g = (const float*)d_in[1]; a.w_in = (const float*)d_in[2]; a.ret_gn_g = (const float*)d_in[3]; a.w_ret_o = (const float*)d_in[4];
    a.q_norm_g = (const float*)d_in[5]; a.k_norm_g = (const float*)d_in[6]; a.sinks = (const float*)d_in[7]; a.w_swa_o = (const float*)d_in[8]; a.w_out = (const float*)d_in[9];
    a.norm_ffn_g = (const float*)d_in[10]; a.w_rg = (const float*)d_in[11]; a.b_rg = (const float*)d_in[12]; a.w_re = (const float*)d_in[13]; a.b_re = (const float*)d_in[14];
    a.w_gate = (const float*)d_in[15]; a.w_up = (const float*)d_in[16]; a.w_down = (const float*)d_in[17];
    a.out = (float*)d_out; a.ws = (unsigned char*)d_ws;
    void* args[] = {&a};
    hipError_t e = hipLaunchCooperativeKernel((const void*)hyb_fwd, dim3(grid), dim3(512), args, LDS_BYTES, stream);
    if (e != hipSuccess) fprintf(stderr, "cooperative launch failed: %s (grid %d)\n", hipGetErrorString(e), grid);
}
```

```cpp
#include <hip/hip_runtime.h>
#include <hip/hip_cooperative_groups.h>
#include <cstdio>
#include <cstdint>
namespace cg = cooperative_groups;
#ifndef PHMASK
#define PHMASK 0xFFFF
#endif
#ifndef WGM_P1
#define WGM_P1 2
#endif
#ifndef WGM_P5
#define WGM_P5 8
#endif
#ifndef WGM_P6
#define WGM_P6 8
#endif
#ifndef ABL
#define ABL 0
#endif
#ifndef PROBE_A
#define PROBE_A -1
#endif
#ifndef PROBE_BASE
#define PROBE_BASE 0
#endif
#ifndef PROBE_B
#define PROBE_B -1
#endif

#define LAS __attribute__((address_space(3)))
typedef unsigned short bf16_t;
typedef short bf16x8 __attribute__((ext_vector_type(8)));
typedef float f32x4 __attribute__((ext_vector_type(4)));
typedef float f32x16 __attribute__((ext_vector_type(16)));
typedef unsigned u32x4 __attribute__((ext_vector_type(4)));
typedef int i32x4 __attribute__((ext_vector_type(4)));
typedef float f32x2 __attribute__((ext_vector_type(2)));
typedef unsigned u32x2 __attribute__((ext_vector_type(2)));
typedef float f32x2_t __attribute__((ext_vector_type(2)));
typedef __bf16 bf16x2_t __attribute__((ext_vector_type(2)));

constexpr int DM = 1024, SEQ = 8192, NTOK = 32768, INW = 5888;
constexpr int NE = 32, DFF = 512;
constexpr float EPS = 1e-6f;
constexpr int LCAP = 32768;

constexpr size_t MiB = 1u << 20;
constexpr size_t WS_CTL = 0;
constexpr size_t WS_WIN = 1 * MiB;
constexpr size_t WS_WRETO = 13 * MiB;
constexpr size_t WS_WSWAO = 15 * MiB;
constexpr size_t WS_WOUT = 16 * MiB;
constexpr size_t WS_WR = 18 * MiB;
constexpr size_t WS_ROT = 19 * MiB;
constexpr size_t WS_SS = 23 * MiB;
constexpr size_t WS_RT = 25 * MiB;
constexpr size_t WS_WGU = 26 * MiB;
constexpr size_t WS_WDT = 90 * MiB;
constexpr size_t WS_H = 122 * MiB;
constexpr size_t WS_QR = 186 * MiB;
constexpr size_t WS_KR = 218 * MiB;
constexpr size_t WS_VT = 250 * MiB;
constexpr size_t WS_GS = 314 * MiB;
constexpr size_t WS_KDT = 378 * MiB;
constexpr size_t WS_SQ = 410 * MiB;
constexpr size_t WS_SK = 442 * MiB;
constexpr size_t WS_SVT = 450 * MiB;
constexpr size_t WS_SW = 458 * MiB;
constexpr size_t WS_LTOK = 490 * MiB;
constexpr size_t WS_LW = 498 * MiB;
constexpr size_t WS_END = 506 * MiB;

constexpr int LDS_BYTES = 147456;
constexpr int LDS_TAB = 131072;

#define DI __device__ __forceinline__
DI unsigned pk2(float lo, float hi) { f32x2_t v = {lo, hi}; bf16x2_t b = __builtin_convertvector(v, bf16x2_t); return __builtin_bit_cast(unsigned, b); }
DI float bflo(unsigned w) { return __uint_as_float(w << 16); }
DI float bfhi(unsigned w) { return __uint_as_float(w & 0xffff0000u); }
DI bf16_t f2bf(float f) { return (bf16_t)(pk2(f, 0.f) & 0xffffu); }
DI float wave_max(float v) {
#pragma unroll
    for (int o = 1; o < 64; o <<= 1) v = fmaxf(v, __shfl_xor(v, o));
    return v;
}
DI float wave_sum(float v) {
#pragma unroll
    for (int o = 1; o < 64; o <<= 1) v += __shfl_xor(v, o);
    return v;
}
DI float sigmoidf_(float v) { return __builtin_amdgcn_rcpf(1.0f + __expf(-v)); }
DI float siluf_(float v) { return v * __builtin_amdgcn_rcpf(1.0f + __expf(-v)); }
#define MFMA32(a, b, c) __builtin_amdgcn_mfma_f32_32x32x16_bf16((a), (b), (c), 0, 0, 0)
DI int crow(int reg, int h) { return (reg & 3) + 8 * (reg >> 2) + 4 * h; }
DI bf16x8 pack8(const f32x16& x, int s) {
    u32x4 p; p.x = pk2(x[8 * s], x[8 * s + 1]); p.y = pk2(x[8 * s + 2], x[8 * s + 3]); p.z = pk2(x[8 * s + 4], x[8 * s + 5]); p.w = pk2(x[8 * s + 6], x[8 * s + 7]);
    return __builtin_bit_cast(bf16x8, p);
}
DI float lg2gamma(int h) { return h == 0 ? -0.04580368961312479f : h == 1 ? -0.02272007650008353f : h == 2 ? -0.011315313227834146f : -0.005646563141142063f; }

DI int colmap_std(int p) { const int bj = p >> 7, wc = (p >> 5) & 3, n = (p >> 4) & 1, fq = (p >> 2) & 3, j = p & 3; return 64 * wc + 32 * bj + 8 * fq + 4 * n + j; }
DI int colmap_gate(int p) { const int bj = p >> 7, wc = (p >> 5) & 3, n = (p >> 4) & 1, fq = (p >> 2) & 3, j = p & 3; return 64 * wc + 16 * fq + 8 * bj + 4 * n + j; }
DI int colmap_rot(int p) { const int bj = p >> 7, wc = (p >> 5) & 3, n = (p >> 4) & 1, fq = (p >> 2) & 3, j = p & 3; return 128 * bj + 64 * n + 16 * wc + 4 * fq + j; }

namespace pg8 {
constexpr int BM = 256, BK = 64, HALF = 128, HTB = HALF * BK * 2, STAGE_BYTES = 8 * HTB, NXCD = 8, WGM = 8;
DI int lds_byte(int r, int c) { const int st = (r >> 4) * 2 + (c >> 5), rr = r & 15, cc = c & 31, ob = rr * 64 + cc * 2; return st * 1024 + (ob ^ (((ob >> 9) & 1) << 5)); }
DI void stage_rc(int b, int& R, int& C) { const int st = b / 1024, sb = b % 1024, swz = sb ^ (((sb >> 9) & 1) << 5); R = (st >> 1) * 16 + swz / 64; C = (st & 1) * 32 + (swz % 64) / 2; }

struct Unit { int pm, pn, g, aux, half; };

template <class Epi, class Sched, int T1 = 0, bool I8 = false, int KT = 0>
DI void gemm_phase(LAS unsigned char* lds, const char* Abase, const int K, const Sched& S, const Epi& E, const char* A2 = nullptr) {
    int tid_ = threadIdx.x; asm volatile("" : "+v"(tid_));
    const int tid = tid_, wid = __builtin_amdgcn_readfirstlane(tid >> 6), lane = tid & 63, wr = wid >> 2, wc = wid & 3, fr = lane & 15, fq = lane >> 4;
    const int nt = KT > 0 ? KT : K / BK;
    int Rr[2], Cc[2]; unsigned voffB[2];
#pragma unroll
    for (int i = 0; i < 2; ++i) { stage_rc(tid * 16 + i * 8192, Rr[i], Cc[i]); voffB[i] = (unsigned)(Rr[i] * K + Cc[i]) * 2u; }
    const size_t kstep = (size_t)(BK * 2);
    const size_t hstep = (size_t)HALF * K * 2;
    const unsigned ldsw = (unsigned)wid * 1024u;
    const int aoff = lds_byte(wr * 64 + fr, fq * 8), boff = lds_byte(wc * 32 + fr, fq * 8);
#define PG8_SA(b, h) (((b) * 2 + (h)) * HTB)
#define PG8_SB(b, h) ((4 + (b) * 2 + (h)) * HTB)
#define PG8_STAGE(bufoff, gbase, voff) do { _Pragma("unroll") for (int _i = 0; _i < 2; ++_i) \
        __builtin_amdgcn_global_load_lds((const unsigned*)((const char*)(gbase) + (voff)[_i]), (LAS unsigned*)(lds + (bufoff) + ldsw + _i * 8192), 16, 0, 0); } while (0)
#define PG8_LDA(dst, b, h) do { _Pragma("unroll") for (int m = 0; m < 4; ++m) _Pragma("unroll") for (int k = 0; k < 2; ++k) dst[m][k] = *(const LAS bf16x8*)(lds + PG8_SA(b, h) + aoff + m * 2048 + k * 1024); } while (0)
#define PG8_LDB(dst, b, h) do { _Pragma("unroll") for (int n = 0; n < 2; ++n) _Pragma("unroll") for (int k = 0; k < 2; ++k) dst[n][k] = *(const LAS bf16x8*)(lds + PG8_SB(b, h) + boff + n * 2048 + k * 1024); } while (0)
#define PG8_MMA(ai, bj, At, Bt) do { __builtin_amdgcn_s_setprio(1); _Pragma("unroll") for (int m = 0; m < 4; ++m) _Pragma("unroll") for (int n = 0; n < 2; ++n) _Pragma("unroll") for (int k = 0; k < 2; ++k) \
        { if constexpr (I8) acc[ai][bj][m][n] = __builtin_bit_cast(f32x4, __builtin_amdgcn_mfma_i32_16x16x64_i8(__builtin_bit_cast(i32x4, Bt[n][k]), __builtin_bit_cast(i32x4, At[m][k]), __builtin_bit_cast(i32x4, acc[ai][bj][m][n]), 0, 0, 0)); \
          else acc[ai][bj][m][n] = __builtin_amdgcn_mfma_f32_16x16x32_bf16(Bt[n][k], At[m][k], acc[ai][bj][m][n], 0, 0, 0); } __builtin_amdgcn_s_setprio(0); } while (0)
#define PG8_WAIT_V(n) asm volatile("s_waitcnt vmcnt(" #n ")" ::: "memory")
#define PG8_WAIT_L(n) asm volatile("s_waitcnt lgkmcnt(" #n ")" ::: "memory")
#define PG8_BAR __builtin_amdgcn_s_barrier()
#define PG8_SCHED __builtin_amdgcn_sched_barrier(0)
    Unit cur, nxt; int ui = 0;
    if (!S.next(0, cur)) return;
    f32x4 acc[2][2][4][2];
#pragma unroll
    for (int a = 0; a < 2; ++a)
#pragma unroll
        for (int b = 0; b < 2; ++b)
#pragma unroll
            for (int m = 0; m < 4; ++m)
#pragma unroll
                for (int n = 0; n < 2; ++n) acc[a][b][m][n] = (f32x4){0.f, 0.f, 0.f, 0.f};
    bf16x8 At[4][2], B0[2][2], B1[2][2];
    unsigned co[2][2], no[2][2];
    S.aoffs(cur, Rr, Cc, co);
    const char* cB = S.bbase(cur);
    PG8_STAGE(PG8_SB(0, 0), cB, voffB); PG8_STAGE(PG8_SB(0, 1), cB + hstep, voffB); PG8_STAGE(PG8_SA(0, 0), Abase, co[0]); PG8_STAGE(PG8_SA(0, 1), Abase, co[1]);
    if (wr == 1) PG8_BAR;
    PG8_WAIT_V(2); PG8_BAR;
    PG8_STAGE(PG8_SB(1, 0), cB + kstep, voffB); PG8_STAGE(PG8_SA(1, 0), Abase + kstep, co[0]); PG8_STAGE(PG8_SB(1, 1), cB + hstep + kstep, voffB);
    PG8_WAIT_V(6); PG8_BAR;
    for (;;) {
        const bool has_next = S.next(ui + 1, nxt);
        const char* nB = has_next ? S.bbase(nxt) : cB;
        if (has_next) S.aoffs(nxt, Rr, Cc, no);
        else { no[0][0] = co[0][0]; no[0][1] = co[0][1]; no[1][0] = co[1][0]; no[1][1] = co[1][1]; }
        for (int t = 0; t < nt; t += 2) {
            const bool last = (t == nt - 2);
            if constexpr (I8) E.stage(lds, cur, wid, lane, ui & 1);
            if constexpr (T1 > 0) if (t == T1) { int fr_ = fr, fq_ = fq; asm volatile("" : "+v"(fr_), "+v"(fq_)); E.mid(acc, cur, wr, wc, fr_, fq_); }
            const bool sg1 = T1 > 0 && t >= T1;
            const bool sg2 = T1 > 0 && !last && t + 2 >= T1;
            const char* a1 = sg1 ? A2 + (size_t)(t + 1 - T1) * kstep : Abase + (size_t)(t + 1) * kstep;
            const char* a2 = last ? Abase : (sg2 ? A2 + (size_t)(t + 2 - T1) * kstep : Abase + (size_t)(t + 2) * kstep); const char* b2 = last ? nB : cB + (size_t)(t + 2) * kstep;
            const char* a3 = a2 + kstep; const char* b3 = b2 + kstep;
            unsigned o1[2], o2[2][2];
            o1[0] = sg1 ? (co[1][0] >> 1) + Cc[0] : co[1][0]; o1[1] = sg1 ? (co[1][1] >> 1) + Cc[1] : co[1][1];
            o2[0][0] = last ? no[0][0] : co[0][0]; o2[0][1] = last ? no[0][1] : co[0][1]; o2[1][0] = last ? no[1][0] : co[1][0]; o2[1][1] = last ? no[1][1] : co[1][1];
            if (sg2) { o2[0][0] = (o2[0][0] >> 1) + Cc[0]; o2[0][1] = (o2[0][1] >> 1) + Cc[1]; o2[1][0] = (o2[1][0] >> 1) + Cc[0]; o2[1][1] = (o2[1][1] >> 1) + Cc[1]; }
            PG8_LDB(B0, 0, 0); PG8_LDB(B1, 0, 1); PG8_SCHED; PG8_LDA(At, 0, 0); PG8_STAGE(PG8_SA(1, 1), a1, o1);
            PG8_WAIT_V(8); PG8_WAIT_L(0); PG8_BAR; if (cur.half != 2) { PG8_MMA(0, 0, At, B0); PG8_MMA(0, 1, At, B1); } PG8_BAR; PG8_SCHED;
            PG8_LDA(At, 0, 1); PG8_STAGE(PG8_SB(0, 0), b2, voffB); PG8_STAGE(PG8_SB(0, 1), b2 + hstep, voffB); PG8_STAGE(PG8_SA(0, 0), a2, o2[0]);
            PG8_WAIT_V(8); PG8_WAIT_L(0); PG8_BAR; if (cur.half != 1) { PG8_MMA(1, 0, At, B0); PG8_MMA(1, 1, At, B1); } PG8_BAR; PG8_SCHED;
            PG8_LDB(B0, 1, 0); PG8_LDB(B1, 1, 1); PG8_SCHED; PG8_LDA(At, 1, 0); PG8_STAGE(PG8_SA(0, 1), a2, o2[1]);
            PG8_WAIT_V(8); PG8_WAIT_L(0); PG8_BAR; if (cur.half != 2) { PG8_MMA(0, 0, At, B0); PG8_MMA(0, 1, At, B1); } PG8_BAR; PG8_SCHED;
            PG8_LDA(At, 1, 1); PG8_STAGE(PG8_SB(1, 0), b3, voffB); PG8_STAGE(PG8_SB(1, 1), b3 + hstep, voffB); PG8_STAGE(PG8_SA(1, 0), a3, o2[0]);
            PG8_WAIT_V(8); PG8_WAIT_L(0); PG8_BAR; if (cur.half != 1) { PG8_MMA(1, 0, At, B0); PG8_MMA(1, 1, At, B1); } PG8_BAR; PG8_SCHED;
        }
        if (wr == 0) PG8_BAR;
        { int fr_ = fr, fq_ = fq; asm volatile("" : "+v"(fr_), "+v"(fq_));
          if constexpr (I8) E.pre(acc, cur, wr, wc, fr_, fq_, (const LAS float*)(lds + 131072 + 8192 + (ui & 1) * 2048));
          E(acc, cur, wr, wc, fr_, fq_); }
        if (!has_next) break;
#pragma unroll
        for (int a = 0; a < 2; ++a)
#pragma unroll
            for (int b = 0; b < 2; ++b)
#pragma unroll
                for (int m = 0; m < 4; ++m)
#pragma unroll
                    for (int n = 0; n < 2; ++n) acc[a][b][m][n] = (f32x4){0.f, 0.f, 0.f, 0.f};
        cur = nxt; cB = nB; co[0][0] = no[0][0]; co[0][1] = no[0][1]; co[1][0] = no[1][0]; co[1][1] = no[1][1]; ++ui;
        if (wr == 1) PG8_BAR;
    }
    PG8_WAIT_V(0);
    PG8_BAR;
#undef PG8_SA
#undef PG8_SB
#undef PG8_STAGE
#undef PG8_LDA
#undef PG8_LDB
#undef PG8_MMA
#undef PG8_WAIT_V
#undef PG8_WAIT_L
#undef PG8_BAR
#undef PG8_SCHED
}

struct DenseOrder {
    int nM, nN, nwg, G, c, K, KA, wgm; const char* Bt;
    DI void init(int M, int N, int K_, int G_, int c_, const void* Bt_, int KA_ = 0, int wgm_ = WGM) { nM = M / BM; nN = N / BM; nwg = nM * nN; G = G_; c = c_; K = K_; KA = KA_ ? KA_ : K_; Bt = (const char*)Bt_; wgm = wgm_; }
    DI bool next(int i, Unit& u) const {
        const long L = (long)i * G + c; if (L >= nwg) return false;
        int wgid = (int)L; { const int q = nwg / NXCD, r = nwg % NXCD, xcd = wgid % NXCD, off = wgid / NXCD; wgid = (xcd < r ? xcd * (q + 1) : r * (q + 1) + (xcd - r) * q) + off; }
        const int nig = wgm * nN, gid = wgid / nig, fm = gid * wgm, gsz = (nM - fm) < wgm ? (nM - fm) : wgm;
        u.pm = fm + ((wgid % nig) % gsz); u.pn = (wgid % nig) / gsz; u.g = 0; u.aux = 0; u.half = 0; return true;
    }
    DI const char* bbase(const Unit& u) const { return Bt + (size_t)u.pn * BM * K * 2; }
    DI void aoffs(const Unit& u, const int (&R)[2], const int (&C)[2], unsigned (&off)[2][2]) const {
#pragma unroll
        for (int h = 0; h < 2; ++h)
#pragma unroll
            for (int i = 0; i < 2; ++i) off[h][i] = (unsigned)((u.pm * BM + h * HALF + R[i]) * KA + C[i]) * 2u;
    }
};

struct GroupOrder {
    const LAS int* tab; int g0, ng, G, c, K, nunits, nfull, nvirt; const char* Bt; size_t bstride;
    const int* ltok; bool gather;
    DI void init(const LAS int* tab_, int g0_, int ng_, int K_, int G_, int c_, const void* Bt_, size_t bstride_, const int* ltok_, bool gather_) {
        tab = tab_; g0 = g0_; ng = ng_; K = K_; G = G_; c = c_; Bt = (const char*)Bt_; bstride = bstride_; ltok = ltok_; gather = gather_;
        nunits = 4 * (tab[64 + g0 + ng] - tab[64 + g0]);
        { const int R = nunits % G; nfull = nunits - R; nvirt = (R > 0 && 2 * R <= G) ? nfull + 2 * R : nunits; if (nvirt == nunits) nfull = nunits; }
    }
    DI bool next(int i, Unit& u) const {
        const long Lv = (long)i * G + c; if (Lv >= nvirt) return false;
        const long L = Lv < nfull ? Lv : nfull + ((Lv - nfull) >> 1);
        u.half = __builtin_amdgcn_readfirstlane(Lv < nfull ? 0 : 1 + (int)((Lv - nfull) & 1));
        int wgid = (int)L; { const int nwg = nunits, q = nwg / NXCD, r = nwg % NXCD, xcd = wgid % NXCD, off = wgid / NXCD; wgid = (xcd < r ? xcd * (q + 1) : r * (q + 1) + (xcd - r) * q) + off; }
        const int T = tab[64 + g0] + (wgid >> 2);
        int g = g0;
        for (int k = g0; k < g0 + ng; ++k) if (tab[64 + k + 1] <= T) g = k + 1;
        u.g = __builtin_amdgcn_readfirstlane(g); u.aux = __builtin_amdgcn_readfirstlane(T - tab[64 + g]); u.pm = __builtin_amdgcn_readfirstlane((tab[192 + g] >> 8) + u.aux); u.pn = wgid & 3; return true;
    }
    DI const char* bbase(const Unit& u) const { return Bt + (size_t)(u.g & 31) * bstride + (size_t)u.pn * BM * K * 2; }
    DI void aoffs(const Unit& u, const int (&R)[2], const int (&C)[2], unsigned (&off)[2][2]) const {
        if (gather) {
            const int cnt = __builtin_amdgcn_readfirstlane(tab[u.g]);
#pragma unroll
            for (int h = 0; h < 2; ++h)
#pragma unroll
                for (int i = 0; i < 2; ++i) { const int rank = u.aux * BM + h * HALF + R[i]; const int tok = rank < cnt ? ltok[(size_t)u.g * LCAP + rank] : 0; off[h][i] = (unsigned)(tok * K + C[i]) * 2u; }
        } else {
#pragma unroll
            for (int h = 0; h < 2; ++h)
#pragma unroll
                for (int i = 0; i < 2; ++i) off[h][i] = (unsigned)((u.pm * BM + h * HALF + R[i]) * K + C[i]) * 2u;
        }
    }
};
}
using pg8::Unit;

#define EPI_ROWS(ai, m) (u.pm * 256 + (ai) * 128 + wr * 64 + (m) * 16 + fr)
typedef f32x4 Acc[2][2][4][2];

DI void store8(bf16_t* p, f32x4 v0, f32x4 v1) { u32x4 w; w.x = pk2(v0[0], v0[1]); w.y = pk2(v0[2], v0[3]); w.z = pk2(v1[0], v1[1]); w.w = pk2(v1[2], v1[3]); *(u32x4*)p = w; }
template <bool ISK> DI void epi_rot(const Acc& acc, const Unit& u, int wr, int wc, int fr, int fq, bf16_t* O, bf16_t* KdT, const float* rcos, const float* rsin, int hb) {
    const float sc = ISK ? 0.08838834764831845f : 1.0f;
    const int i0 = 16 * wc + 4 * fq;
#pragma unroll
    for (int ai = 0; ai < 2; ++ai)
#pragma unroll
        for (int m = 0; m < 4; ++m) {
            const int row = EPI_ROWS(ai, m), pos = row & (SEQ - 1), b = row >> 13;
            const f32x4 c4 = *(const f32x4*)(rcos + pos * 64 + i0), s4 = *(const f32x4*)(rsin + pos * 64 + i0);
#pragma unroll
            for (int bj = 0; bj < 2; ++bj) {
                const int head = hb + bj;
                const f32x4 x1 = acc[ai][bj][m][0], x2 = acc[ai][bj][m][1];
                const f32x4 o1 = (x1 * c4 - x2 * s4) * sc, o2 = (x1 * s4 + x2 * c4) * sc;
                bf16_t* op = O + (size_t)row * 512 + head * 128 + i0;
                u32x2 w1, w2; w1.x = pk2(o1[0], o1[1]); w1.y = pk2(o1[2], o1[3]); w2.x = pk2(o2[0], o2[1]); w2.y = pk2(o2[2], o2[3]);
                *(u32x2*)op = w1; *(u32x2*)(op + 64) = w2;
                if (ISK && !(ABL & 256)) {
                    const float dec = __builtin_amdgcn_exp2f((float)(127 - (pos & 127)) * lg2gamma(head));
                    bf16_t* tp = KdT + ((size_t)((b * 4 + head) * 128 + i0)) * SEQ + pos;
                    tp[0] = f2bf(o1[0] * dec); tp[(size_t)1 * SEQ] = f2bf(o1[1] * dec); tp[(size_t)2 * SEQ] = f2bf(o1[2] * dec); tp[(size_t)3 * SEQ] = f2bf(o1[3] * dec);
                    tp[(size_t)64 * SEQ] = f2bf(o2[0] * dec); tp[(size_t)65 * SEQ] = f2bf(o2[1] * dec); tp[(size_t)66 * SEQ] = f2bf(o2[2] * dec); tp[(size_t)67 * SEQ] = f2bf(o2[3] * dec);
                }
            }
            asm volatile("" ::: "memory");
        }
}
DI void epi_tr(const Acc& acc, const Unit& u, int wr, int wc, int fr, int fq, bf16_t* TP, int nrow_b, int rowoff, int bjmul) {
    char* tb = (char*)TP;
#pragma unroll
    for (int ai = 0; ai < 2; ++ai)
#pragma unroll
        for (int m = 0; m < 4; ++m) {
            const int row = EPI_ROWS(ai, m), pos = row & (SEQ - 1), b = row >> 13;
            const unsigned o0 = (unsigned)((b * nrow_b + rowoff + 8 * fq) * SEQ + pos) * 2u;
#pragma unroll
            for (int bj = 0; bj < 2; ++bj)
#pragma unroll
                for (int n = 0; n < 2; ++n) {
                    const unsigned o = o0 + (unsigned)((bjmul * bj + 4 * n) * SEQ) * 2u;
                    const f32x4 v = acc[ai][bj][m][n];
                    if (!(ABL & 256)) { *(bf16_t*)(tb + o) = f2bf(v[0]); *(bf16_t*)(tb + o + 2u * SEQ) = f2bf(v[1]); *(bf16_t*)(tb + o + 4u * SEQ) = f2bf(v[2]); *(bf16_t*)(tb + o + 6u * SEQ) = f2bf(v[3]); }
                }
            asm volatile("" ::: "memory");
        }
}
template <bool SIL> DI void epi_gate(const Acc& acc, const Unit& u, int wr, int wc, int fr, int fq, bf16_t* O, int cb) {
#pragma unroll
    for (int ai = 0; ai < 2; ++ai)
#pragma unroll
        for (int m = 0; m < 4; ++m) {
            const int row = EPI_ROWS(ai, m);
#pragma unroll
            for (int bj = 0; bj < 2; ++bj) {
                f32x4 v0 = acc[ai][bj][m][0], v1 = acc[ai][bj][m][1];
                if (SIL) { v0 = (f32x4){siluf_(v0[0]), siluf_(v0[1]), siluf_(v0[2]), siluf_(v0[3])}; v1 = (f32x4){siluf_(v1[0]), siluf_(v1[1]), siluf_(v1[2]), siluf_(v1[3])}; }
                else { v0 = (f32x4){sigmoidf_(v0[0]), sigmoidf_(v0[1]), sigmoidf_(v0[2]), sigmoidf_(v0[3])}; v1 = (f32x4){sigmoidf_(v1[0]), sigmoidf_(v1[1]), sigmoidf_(v1[2]), sigmoidf_(v1[3])}; }
                store8(O + (size_t)row * 1024 + cb + 64 * wc + 32 * bj + 8 * fq, v0, v1);
            }
            asm volatile("" ::: "memory");
        }
}
template <int LO> DI void epi_gate_q(const Acc& acc, const Unit& u, int wr, int wc, int fr, int fq, unsigned char* O, int cb) {
#pragma unroll
    for (int ai = 0; ai < 2; ++ai)
#pragma unroll
        for (int m = 0; m < 4; ++m) {
            const int row = EPI_ROWS(ai, m);
            u32x4 w;
#pragma unroll
            for (int bj = 0; bj < 2; ++bj)
#pragma unroll
                for (int n = 0; n < 2; ++n) {
                    const f32x4 v = acc[ai][bj][m][n];
                    unsigned q = 0;
#pragma unroll
                    for (int j = 0; j < 4; ++j) { const float e = __builtin_amdgcn_exp2f(v[j] * -1.4426950408889634f); float f = __builtin_amdgcn_rcpf(__builtin_fmaf(e, 1.0f / 255.0f, 1.0f / 255.0f)); if (LO) f = fmaxf(f, (float)LO); q = __builtin_amdgcn_cvt_pk_u8_f32(f, j, q); }
                    w[2 * bj + n] = q;
                }
            *(u32x4*)(O + (size_t)row * 1024 + cb + 64 * wc + 16 * fq) = w;
            asm volatile("" ::: "memory");
        }
}
DI void epi_qknorm(const Acc& acc, const Unit& u, int wr, int wc, int fr, int fq, bf16_t* O, int pitch, int coff, const float* gw, float sc) {
    const f32x4 g00 = *(const f32x4*)(gw + 8 * fq) * sc, g01 = *(const f32x4*)(gw + 8 * fq + 4) * sc, g10 = *(const f32x4*)(gw + 32 + 8 * fq) * sc, g11 = *(const f32x4*)(gw + 32 + 8 * fq + 4) * sc;
#pragma unroll
    for (int ai = 0; ai < 2; ++ai)
#pragma unroll
        for (int m = 0; m < 4; ++m) {
            const int row = EPI_ROWS(ai, m);
            float ss = 0.f;
#pragma unroll
            for (int bj = 0; bj < 2; ++bj)
#pragma unroll
                for (int n = 0; n < 2; ++n) { const f32x4 v = acc[ai][bj][m][n]; ss += (v[0] * v[0] + v[1] * v[1]) + (v[2] * v[2] + v[3] * v[3]); }
            ss += __shfl_xor(ss, 16); ss += __shfl_xor(ss, 32);
            const float r = __builtin_amdgcn_rsqf(ss * (1.0f / 64.0f) + EPS);
            bf16_t* op = O + (size_t)row * pitch + coff + 8 * fq;
            store8(op, acc[ai][0][m][0] * r * g00, acc[ai][0][m][1] * r * g01);
            store8(op + 32, acc[ai][1][m][0] * r * g10, acc[ai][1][m][1] * r * g11);
            asm volatile("" ::: "memory");
        }
}
struct EpiProj {
    bf16_t *Qr, *Kr, *KdT, *VT, *Gs, *SQ, *SK, *SVT; unsigned char *GA, *GB; const float *rcos, *rsin, *qng, *kng; const float *hs, *csc;
    DI void stage(LAS unsigned char* lds, const Unit& u, int wid, int lane, int par) const {
        const float* src = (wid < 4 ? csc + u.pn * 256 + wid * 64 : hs + u.pm * 256 + (wid - 4) * 64) + lane;
        __builtin_amdgcn_global_load_lds((const unsigned*)src, (LAS unsigned*)(lds + 131072 + 8192 + par * 2048 + wid * 256), 4, 0, 0);
    }
    DI void pre(Acc& acc, const Unit& u, int wr, int wc, int fr, int fq, const LAS float* sc) const {
        f32x4 cs[2][2];
#pragma unroll
        for (int bj = 0; bj < 2; ++bj)
#pragma unroll
            for (int n = 0; n < 2; ++n) cs[bj][n] = *(const LAS f32x4*)(sc + 128 * bj + 32 * wc + 16 * n + 4 * fq);
#pragma unroll
        for (int ai = 0; ai < 2; ++ai)
#pragma unroll
            for (int m = 0; m < 4; ++m) {
                const float rs = sc[256 + ai * 128 + wr * 64 + m * 16 + fr];
#pragma unroll
                for (int bj = 0; bj < 2; ++bj)
#pragma unroll
                    for (int n = 0; n < 2; ++n) {
                        const i32x4 iv = __builtin_bit_cast(i32x4, acc[ai][bj][m][n]);
                        f32x4 v; v[0] = (float)iv[0]; v[1] = (float)iv[1]; v[2] = (float)iv[2]; v[3] = (float)iv[3];
                        acc[ai][bj][m][n] = v * cs[bj][n] * rs;
                    }
            }
    }
    DI void operator()(const Acc& acc, const Unit& u, int wr, int wc, int fr, int fq) const {
        const int pn = u.pn;
        if (pn < 2) epi_rot<false>(acc, u, wr, wc, fr, fq, Qr, nullptr, rcos, rsin, 2 * pn);
        else if (pn < 4) epi_rot<true>(acc, u, wr, wc, fr, fq, Kr, KdT, rcos, rsin, 2 * (pn - 2));
        else if (pn < 8) epi_tr(acc, u, wr, wc, fr, fq, VT, 1024, (pn - 4) * 256 + 64 * wc, 32);
        else if (pn < 12) epi_gate<true>(acc, u, wr, wc, fr, fq, Gs, (pn - 8) * 256);
        else if (pn < 14) epi_qknorm(acc, u, wr, wc, fr, fq, SQ, 512, ((pn - 12) * 4 + wc) * 64, qng, 0.125f);
        else if (pn == 14) {
            if (wc < 2) epi_qknorm(acc, u, wr, wc, fr, fq, SK, 128, wc * 64, kng, 1.0f);
            else epi_tr(acc, u, wr, wc, fr, fq, SVT, 128, (wc - 2) * 64, 32);
        }
        else if (pn < 19) epi_gate_q<0>(acc, u, wr, wc, fr, fq, GA, (pn - 15) * 256);
        else epi_gate_q<1>(acc, u, wr, wc, fr, fq, GB, (pn - 19) * 256);
    }
};

struct EpiMerge {
    const unsigned char* GA; const unsigned char* GB; bf16_t* MG;
    DI void mid(Acc& acc, const Unit& u, int wr, int wc, int fr, int fq) const {
        u32x2 a[2][4][2], b[2][4][2];
#pragma unroll
        for (int ai = 0; ai < 2; ++ai)
#pragma unroll
            for (int m = 0; m < 4; ++m)
#pragma unroll
                for (int bj = 0; bj < 2; ++bj) { const size_t o = (size_t)EPI_ROWS(ai, m) * 1024 + u.pn * 256 + 64 * wc + 16 * fq + 8 * bj;
                    if (ABL & 1) { a[ai][m][bj] = (u32x2){0x01010101u, 0x01010101u}; b[ai][m][bj] = a[ai][m][bj]; } else { a[ai][m][bj] = *(const u32x2*)(GA + o); b[ai][m][bj] = *(const u32x2*)(GB + o); } }
#pragma unroll
        for (int ai = 0; ai < 2; ++ai)
#pragma unroll
            for (int m = 0; m < 4; ++m)
#pragma unroll
                for (int bj = 0; bj < 2; ++bj) {
                    const u32x2 av = a[ai][m][bj], bv = b[ai][m][bj];
                    f32x4 r0, r1;
#pragma unroll
                    for (int j = 0; j < 4; ++j) {
                        r0[j] = (float)((av.x >> (8 * j)) & 255u) * __builtin_amdgcn_rcpf((float)((bv.x >> (8 * j)) & 255u));
                        r1[j] = (float)((av.y >> (8 * j)) & 255u) * __builtin_amdgcn_rcpf((float)((bv.y >> (8 * j)) & 255u));
                    }
                    acc[ai][bj][m][0] = acc[ai][bj][m][0] * r0; acc[ai][bj][m][1] = acc[ai][bj][m][1] * r1;
                }
    }
    DI void operator()(const Acc& acc, const Unit& u, int wr, int wc, int fr, int fq) const {
        u32x2 gv[2][4][2];
#pragma unroll
        for (int ai = 0; ai < 2; ++ai)
#pragma unroll
            for (int m = 0; m < 4; ++m)
#pragma unroll
                for (int bj = 0; bj < 2; ++bj) gv[ai][m][bj] = (ABL & 2) ? (u32x2){0x01010101u, 0x01010101u} : *(const u32x2*)(GB + (size_t)EPI_ROWS(ai, m) * 1024 + u.pn * 256 + 64 * wc + 16 * fq + 8 * bj);
#pragma unroll
        for (int ai = 0; ai < 2; ++ai) {
#pragma unroll
            for (int m = 0; m < 4; ++m)
#pragma unroll
                for (int bj = 0; bj < 2; ++bj) {
                    const size_t o = (size_t)EPI_ROWS(ai, m) * 1024 + u.pn * 256 + 64 * wc + 16 * fq + 8 * bj;
                    const u32x2 g = gv[ai][m][bj];
                    const f32x4 a0 = acc[ai][bj][m][0] * (1.0f / 255.0f), a1 = acc[ai][bj][m][1] * (1.0f / 255.0f);
                    float v[8];
#pragma unroll
                    for (int j = 0; j < 4; ++j) { v[j] = (float)((g.x >> (8 * j)) & 255u) * a0[j]; v[4 + j] = (float)((g.y >> (8 * j)) & 255u) * a1[j]; }
                    u32x4 w; w.x = pk2(v[0], v[1]); w.y = pk2(v[2], v[3]); w.z = pk2(v[4], v[5]); w.w = pk2(v[6], v[7]);
                    *(u32x4*)(MG + o) = w;
                }
            asm volatile("" ::: "memory");
        }
    }
};

struct EpiOut {
    const float* x; bf16_t* XB; float* SS;
    DI void operator()(const Acc& acc, const Unit& u, int wr, int wc, int fr, int fq) const {
#pragma unroll
        for (int ai = 0; ai < 2; ++ai) {
            f32x4 xv[4][2][2];
#pragma unroll
            for (int m = 0; m < 4; ++m)
#pragma unroll
                for (int bj = 0; bj < 2; ++bj) { const size_t o = (size_t)EPI_ROWS(ai, m) * 1024 + u.pn * 256 + 64 * wc + 32 * bj + 8 * fq; if (ABL & 8) { xv[m][bj][0] = (f32x4){0.f, 0.f, 0.f, 0.f}; xv[m][bj][1] = xv[m][bj][0]; } else { xv[m][bj][0] = *(const f32x4*)(x + o); xv[m][bj][1] = *(const f32x4*)(x + o + 4); } }
#pragma unroll
            for (int m = 0; m < 4; ++m) {
                const int row = EPI_ROWS(ai, m);
                float ss = 0.f;
#pragma unroll
                for (int bj = 0; bj < 2; ++bj) {
                    const size_t o = (size_t)row * 1024 + u.pn * 256 + 64 * wc + 32 * bj + 8 * fq;
                    const f32x4 x0 = xv[m][bj][0] + acc[ai][bj][m][0], x1 = xv[m][bj][1] + acc[ai][bj][m][1];
                    ss += (x0[0] * x0[0] + x0[1] * x0[1]) + (x0[2] * x0[2] + x0[3] * x0[3]) + (x1[0] * x1[0] + x1[1] * x1[1]) + (x1[2] * x1[2] + x1[3] * x1[3]);
                    u32x4 w; w.x = pk2(x0[0], x0[1]); w.y = pk2(x0[2], x0[3]); w.z = pk2(x1[0], x1[1]); w.w = pk2(x1[2], x1[3]);
                    *(u32x4*)(XB + o) = w;
                }
                ss += __shfl_xor(ss, 16); ss += __shfl_xor(ss, 32);
                if (fq == 0) SS[(size_t)row * 16 + u.pn * 4 + wc] = ss;
            }
            asm volatile("" ::: "memory");
        }
    }
};

struct EpiRouter {
    float* LOG;
    DI void operator()(const Acc& acc, const Unit& u, int wr, int wc, int fr, int fq) const {
        if (wc != 0) return;
#pragma unroll
        for (int ai = 0; ai < 2; ++ai)
#pragma unroll
            for (int m = 0; m < 4; ++m) {
                const int row = EPI_ROWS(ai, m);
#pragma unroll
                for (int bj = 0; bj < 2; ++bj) { float* p = LOG + (size_t)row * 64 + 32 * bj + 8 * fq; *(f32x4*)p = acc[ai][bj][m][0]; *(f32x4*)(p + 4) = acc[ai][bj][m][1]; }
            }
    }
};

struct EpiUp {
    bf16_t* HM; const LAS int* tab; const f32x2* lrx; const float* ecs;
    DI void stage(LAS unsigned char*, const Unit&, int, int, int) const {}
    DI void pre(Acc& acc, const Unit& u, int wr, int wc, int fr, int fq, const LAS float*) const {
        const int cnt = tab[u.g];
        float rs[2][4];
#pragma unroll
        for (int ai = 0; ai < 2; ++ai)
#pragma unroll
            for (int m = 0; m < 4; ++m) { const int rank = u.aux * 256 + ai * 128 + wr * 64 + m * 16 + fr; const f32x2 pr_ = lrx[(size_t)u.g * LCAP + (rank < cnt ? rank : 0)]; rs[ai][m] = pr_.x * pr_.y; }
#pragma unroll
        for (int bj = 0; bj < 2; ++bj)
#pragma unroll
            for (int n = 0; n < 2; ++n) {
                const f32x4 cs = *(const f32x4*)(ecs + (u.g & 31) * 1024 + u.pn * 256 + 128 * bj + 32 * wc + 16 * n + 4 * fq);
#pragma unroll
                for (int ai = 0; ai < 2; ++ai)
#pragma unroll
                    for (int m = 0; m < 4; ++m) {
                        const i32x4 iv = __builtin_bit_cast(i32x4, acc[ai][bj][m][n]);
                        f32x4 v; v[0] = (float)iv[0]; v[1] = (float)iv[1]; v[2] = (float)iv[2]; v[3] = (float)iv[3];
                        acc[ai][bj][m][n] = v * cs * rs[ai][m];
                    }
                asm volatile("" ::: "memory");
            }
    }
    DI void operator()(const Acc& acc, const Unit& u, int wr, int wc, int fr, int fq) const {
        const int cnt = tab[u.g];
        float rv[2][4];
#pragma unroll
        for (int ai = 0; ai < 2; ++ai)
#pragma unroll
            for (int m = 0; m < 4; ++m) rv[ai][m] = 1.0f;
#pragma unroll
        for (int ai = 0; ai < 2; ++ai)
#pragma unroll
            for (int m = 0; m < 4; ++m) {
                const int lr = ai * 128 + wr * 64 + m * 16 + fr, rank = u.aux * 256 + lr;
                if (rank < cnt && (u.half == 0 || u.half == ai + 1)) {
                    const float r = rv[ai][m];
                    float v[8];
#pragma unroll
                    for (int n = 0; n < 2; ++n)
#pragma unroll
                        for (int j = 0; j < 4; ++j) { const float g = acc[ai][0][m][n][j] * r, up = acc[ai][1][m][n][j] * r; v[4 * n + j] = siluf_(g) * up; }
                    u32x4 w; w.x = pk2(v[0], v[1]); w.y = pk2(v[2], v[3]); w.z = pk2(v[4], v[5]); w.w = pk2(v[6], v[7]);
                    *(u32x4*)(HM + (size_t)(u.pm * 256 + lr) * DFF + u.pn * 128 + 32 * wc + 8 * fq) = w;
                }
            }
    }
};

struct XcdBarrier;
__device__ __forceinline__ void xcd_wait(const XcdBarrier& b, volatile LAS unsigned* sv);
template <int SLOT> struct EpiDown {
    const bf16_t* In; bf16_t* YB; float* out; const LAS int* tab; const int* ltok; const float* lw; const XcdBarrier* xb; volatile LAS unsigned* sv;
    DI void operator()(const Acc& acc, const Unit& u, int wr, int wc, int fr, int fq) const {
        const int cnt = tab[u.g];
        if (SLOT == 1) { if (sv[3] == 0u) { xcd_wait(*xb, sv); if (threadIdx.x == 0) sv[3] = 1u; asm volatile("s_waitcnt lgkmcnt(0)" ::: "memory"); __builtin_amdgcn_s_barrier(); } }
        int tk[2][4]; float wv[2][4];
#pragma unroll
        for (int ai = 0; ai < 2; ++ai)
#pragma unroll
            for (int m = 0; m < 4; ++m) { const int rank = u.aux * 256 + ai * 128 + wr * 64 + m * 16 + fr; const size_t li = (size_t)u.g * LCAP + (rank < cnt ? rank : 0); tk[ai][m] = ltok[li]; wv[ai][m] = lw[li]; }
        u32x4 bv[2][4][2];
#pragma unroll
        for (int ai = 0; ai < 2; ++ai)
#pragma unroll
            for (int m = 0; m < 4; ++m)
#pragma unroll
                for (int bj = 0; bj < 2; ++bj) bv[ai][m][bj] = (ABL & 4) ? (u32x4){0u, 0u, 0u, 0u} : *(const u32x4*)(In + (size_t)tk[ai][m] * 1024 + u.pn * 256 + 64 * wc + 32 * bj + 8 * fq);
#pragma unroll
        for (int ai = 0; ai < 2; ++ai) {
#pragma unroll
            for (int m = 0; m < 4; ++m) {
                const int rank = u.aux * 256 + ai * 128 + wr * 64 + m * 16 + fr;
                if (rank < cnt && (u.half == 0 || u.half == ai + 1)) {
                    const float w = wv[ai][m];
#pragma unroll
                    for (int bj = 0; bj < 2; ++bj) {
                        const size_t o = (size_t)tk[ai][m] * 1024 + u.pn * 256 + 64 * wc + 32 * bj + 8 * fq;
                        const u32x4 b = bv[ai][m][bj];
                        const f32x4 a0 = acc[ai][bj][m][0] * w, a1 = acc[ai][bj][m][1] * w;
                        const f32x4 o0 = (f32x4){bflo(b.x), bfhi(b.x), bflo(b.y), bfhi(b.y)} + a0, o1 = (f32x4){bflo(b.z), bfhi(b.z), bflo(b.w), bfhi(b.w)} + a1;
                        if (SLOT == 0) { u32x4 wvv; wvv.x = pk2(o0[0], o0[1]); wvv.y = pk2(o0[2], o0[3]); wvv.z = pk2(o1[0], o1[1]); wvv.w = pk2(o1[2], o1[3]); *(u32x4*)(YB + o) = wvv; }
                        else { *(f32x4*)(out + o) = o0; *(f32x4*)(out + o + 4) = o1; }
                    }
                }
            }
            asm volatile("" ::: "memory");
        }
    }
};

#define XB_TMO      128
#define XB_XCNT(j)  (256  + 64 * (j))
#define XB_XSUB(j)  (1280 + 64 * (j))
#define XB_XGEN(j)  (2304 + 64 * (j))
#define XB_TOP      3328
#define XB_TOPGEN   3392
#define XCD_BAR_WORDS 3456
#define XB_SPIN_CAP (1u << 20)
DI unsigned xb_ld(unsigned* p)              { return __hip_atomic_load(p, __ATOMIC_RELAXED, __HIP_MEMORY_SCOPE_AGENT); }
DI unsigned xb_add(unsigned* p, unsigned v) { return __hip_atomic_fetch_add(p, v, __ATOMIC_RELAXED, __HIP_MEMORY_SCOPE_AGENT); }
DI unsigned xb_xcc_id() { return (unsigned)__builtin_amdgcn_s_getreg((3 << 11) | 20) & 0xFu; }
#define XB_SPIN(cond, bar) do { unsigned _sp = 0; while (cond) { __builtin_amdgcn_s_sleep(1); \
    if ((++_sp & 255u) == 0u) { if (xb_ld(&(bar)[XB_TMO])) break; if (_sp > XB_SPIN_CAP) { atomicAdd(&(bar)[XB_TMO], 1u); break; } } } } while (0)
struct XcdBarrier { unsigned* bar; unsigned x; volatile LAS unsigned* st; };
DI XcdBarrier xcd_barrier_post(unsigned* bar, volatile LAS unsigned* st) {
    XcdBarrier b; b.bar = bar; b.x = xb_xcc_id(); b.st = st;
    if (threadIdx.x == 0) (void)xb_add(&bar[XB_XCNT(b.x)], 1u);
    return b;
}
DI void xcd_barrier_complete(unsigned* bar, unsigned x, unsigned& nloc, unsigned& nx) {
    const unsigned G = gridDim.x * gridDim.y * gridDim.z;
    unsigned sum, cnt, mine, sp = 0u;
    for (;;) {
        sum = 0u; cnt = 0u; mine = 0u;
#pragma unroll
        for (unsigned j = 0; j < 16; ++j) { const unsigned c = xb_ld(&bar[XB_XCNT(j)]); sum += c; cnt += (c > 0u) ? 1u : 0u; mine = (j == x) ? c : mine; }
        if (sum == G) break;
        __builtin_amdgcn_s_sleep(1);
        if ((++sp & 255u) == 0u) { if (xb_ld(&bar[XB_TMO])) break; if (sp > XB_SPIN_CAP) { atomicAdd(&bar[XB_TMO], 1u); break; } }
    }
    nloc = mine > 0u ? mine : 1u; nx = cnt > 0u ? cnt : 1u;
}
DI void xcd_barrier(const XcdBarrier& b) {
    asm volatile("s_waitcnt vmcnt(0)" ::: "memory");
    __syncthreads();
    if (threadIdx.x == 0) {
        unsigned* bar = b.bar;
        __builtin_amdgcn_s_waitcnt(0);
        unsigned nloc = b.st[0], nx = b.st[1];
        if (nloc == 0u) { xcd_barrier_complete(bar, b.x, nloc, nx); b.st[0] = nloc; b.st[1] = nx; }
        const unsigned old = xb_add(&bar[XB_XSUB(b.x)], 1u);
        const unsigned gen = old / nloc;
        if (old + 1u == (gen + 1u) * nloc) {
            __builtin_amdgcn_fence(__ATOMIC_RELEASE, "agent");
            asm volatile("s_waitcnt vmcnt(0)" ::: "memory");
            const unsigned og = xb_add(&bar[XB_TOP], 1u);
            const unsigned tg = og / nx;
            if (og + 1u == (tg + 1u) * nx) xb_add(&bar[XB_TOPGEN], 1u);
            else XB_SPIN((int)(xb_ld(&bar[XB_TOPGEN]) - tg) <= 0, bar);
        } else {
            XB_SPIN((int)(xb_ld(&bar[XB_TOPGEN]) - gen) <= 0, bar);
        }
        __builtin_amdgcn_fence(__ATOMIC_ACQUIRE, "agent");
        asm volatile("s_waitcnt vmcnt(0)" ::: "memory");
    }
    __syncthreads();
}


DI void xcd_arrive(const XcdBarrier& b, volatile LAS unsigned* sv) {
    asm volatile("s_waitcnt vmcnt(0)" ::: "memory");
    __syncthreads();
    if (threadIdx.x == 0) {
        unsigned* bar = b.bar;
        __builtin_amdgcn_s_waitcnt(0);
        unsigned nloc = b.st[0], nx = b.st[1];
        if (nloc == 0u) { xcd_barrier_complete(bar, b.x, nloc, nx); b.st[0] = nloc; b.st[1] = nx; }
        const unsigned old = xb_add(&bar[XB_XSUB(b.x)], 1u);
        const unsigned gen = old / nloc;
        sv[1] = gen;
        if (old + 1u == (gen + 1u) * nloc) {
            __builtin_amdgcn_fence(__ATOMIC_RELEASE, "agent");
            asm volatile("s_waitcnt vmcnt(0)" ::: "memory");
            const unsigned og = xb_add(&bar[XB_TOP], 1u);
            const unsigned tg = og / nx;
            if (og + 1u == (tg + 1u) * nx) xb_add(&bar[XB_TOPGEN], 1u);
            sv[0] = 1u; sv[2] = tg;
        } else sv[0] = 0u;
    }
    __syncthreads();
}
DI void xcd_wait(const XcdBarrier& b, volatile LAS unsigned* sv) {
    if (threadIdx.x == 0) {
        unsigned* bar = b.bar;
        const unsigned gen = sv[1];
        XB_SPIN((int)(xb_ld(&bar[XB_TOPGEN]) - gen) <= 0, bar);
        __builtin_amdgcn_fence(__ATOMIC_ACQUIRE, "agent");
        asm volatile("s_waitcnt vmcnt(0)" ::: "memory");
    }
    asm volatile("s_waitcnt lgkmcnt(0)" ::: "memory");
    __builtin_amdgcn_s_barrier();
}

template <int RB> DI int swz(int row, int chunk) { return row * RB + ((RB == 128 ? (chunk ^ ((row >> 1) & 7)) : (chunk ^ (row & 15))) << 4); }
template <int RB> DI void stage_tile(LAS unsigned char* lds, int loff, const char* g, size_t gpitch, int nrows, int wave, int lane) {
    constexpr int RPI = 1024 / RB, LPR = RB / 16;
    for (int r0 = wave * RPI; r0 < nrows; r0 += 8 * RPI) {
        const int row = r0 + lane / LPR, slot = lane % LPR;
        const int chunk = RB == 128 ? (slot ^ ((row >> 1) & 7)) : (slot ^ (row & 15));
        __builtin_amdgcn_global_load_lds((const unsigned*)(g + (size_t)row * gpitch + chunk * 16), (LAS unsigned*)(lds + loff + r0 * RB), 16, 0, 0);
    }
}
#define LDS_V16(off) (*(const LAS bf16x8*)(lds + (off)))
#define LDS_V8(off) (*(const LAS u32x2*)(lds + (off)))

struct Args {
    const float *x, *norm_mix_g, *w_in, *ret_gn_g, *w_ret_o, *q_norm_g, *k_norm_g, *sinks, *w_swa_o, *w_out, *norm_ffn_g, *w_rg, *b_rg, *w_re, *b_re, *w_gate, *w_up, *w_down;
    float* out; unsigned char* ws;
};

struct TrItem { f32x4 v[8]; float sc[8]; bf16_t* WT; int K, p0, k0; };
__device__ const float k_ones[1024] = {
#define O16 1.f,1.f,1.f,1.f,1.f,1.f,1.f,1.f,1.f,1.f,1.f,1.f,1.f,1.f,1.f,1.f
#define O256 O16,O16,O16,O16,O16,O16,O16,O16,O16,O16,O16,O16,O16,O16,O16,O16
    O256, O256, O256, O256
#undef O256
#undef O16
};
DI void tr_load(TrItem& t, const float* colp4, int ldn, bf16_t* WT, int K, int p0, int k0, int lane, const float* ks) {
    t.WT = WT; t.K = K; t.p0 = p0; t.k0 = k0;
#pragma unroll
    for (int i = 0; i < 8; ++i) t.v[i] = *(const f32x4*)(colp4 + (size_t)(k0 + i * 8 + (lane >> 3)) * ldn);
#pragma unroll
    for (int i = 0; i < 8; ++i) t.sc[i] = ((const __attribute__((address_space(1))) float*)ks)[k0 + i * 8 + (lane >> 3)];
}
DI void tr_finish(const TrItem& t, LAS float* scr, int lane) {
    const int c4 = lane & 7;
#pragma unroll
    for (int i = 0; i < 8; ++i) { LAS float* d = scr + (i * 8 + (lane >> 3)) * 33 + 4 * c4; const float sc = t.sc[i]; d[0] = t.v[i][0] * sc; d[1] = t.v[i][1] * sc; d[2] = t.v[i][2] * sc; d[3] = t.v[i][3] * sc; }
    asm volatile("s_waitcnt lgkmcnt(0)" ::: "memory");
    const int c = lane & 7;
#pragma unroll
    for (int j = 0; j < 4; ++j) { const int n = (lane >> 3) + 8 * j; const LAS float* s = scr + (8 * c) * 33 + n;
        u32x4 o; o.x = pk2(s[0 * 33], s[1 * 33]); o.y = pk2(s[2 * 33], s[3 * 33]); o.z = pk2(s[4 * 33], s[5 * 33]); o.w = pk2(s[6 * 33], s[7 * 33]);
        *(u32x4*)(t.WT + (size_t)(t.p0 + n) * t.K + t.k0 + 8 * c) = o; }
    asm volatile("s_waitcnt lgkmcnt(0)" ::: "memory");
}
DI void sincos_d(double a, double& s, double& c) {
    const double q = __builtin_rint(a * 0.63661977236758134308);
    const double r = (a - q * 1.57079632679489655800) - q * 6.12323399573676603587e-17;
    const double r2 = r * r;
    double sp = r * (1.0 + r2 * (-1.0 / 6 + r2 * (1.0 / 120 + r2 * (-1.0 / 5040 + r2 * (1.0 / 362880 + r2 * (-1.0 / 39916800 + r2 * (1.0 / 6227020800.0)))))));
    double cp = 1.0 + r2 * (-0.5 + r2 * (1.0 / 24 + r2 * (-1.0 / 720 + r2 * (1.0 / 40320 + r2 * (-1.0 / 3628800 + r2 * (1.0 / 479001600.0 + r2 * (-1.0 / 87178291200.0)))))));
    const int qi = ((int)q) & 3;
    s = (qi == 0) ? sp : (qi == 1) ? cp : (qi == 2) ? -sp : -cp;
    c = (qi == 0) ? cp : (qi == 1) ? -sp : (qi == 2) ? -cp : sp;
}

constexpr int CEXP0 = 12288, CEXP1 = 8192;
constexpr int CI0 = 16 * 184, CI1 = 16 * 32, CI2 = 8 * 32, CI3 = 16 * 32, CI4 = 16 * 2, CIU = 32 * 16 * 32, CID = 32 * 8 * 32, CNS = CI0 + CI1 + CI2 + CI3 + CI4, CNI = CNS + CIU + CID;
DI void conv_items(const Args& A, unsigned char* ws, LAS float* scr, int lane, int lo, int hi, int w0, int nw) {
    bf16_t* WinT = (bf16_t*)(ws + WS_WIN); bf16_t* WretoT = (bf16_t*)(ws + WS_WRETO); bf16_t* WoutT = (bf16_t*)(ws + WS_WOUT); bf16_t* WrT = (bf16_t*)(ws + WS_WR);
    bf16_t* Wgu = (bf16_t*)(ws + WS_WGU); bf16_t* WdT = (bf16_t*)(ws + WS_WDT);
    constexpr int I0 = CI0, I1 = CI1, I2 = CI2, I3 = CI3, I4 = CI4, IU = CIU;
    const int c4 = lane & 7;
    auto issue = [&](TrItem& t, int it) {
        int r = it;
        const float* src; int ldn, K, p0, k0; bf16_t* WT; const float* ks = k_ones;
        if (r < I0) { const int kb = r / 184, pb = r % 184, p = pb * 32 + 4 * c4, tile = p >> 8;
            src = A.w_in + tile * 256 + (tile < 4 ? colmap_rot(p & 255) : (tile >= 15 ? colmap_gate(p & 255) : colmap_std(p & 255))); ldn = INW; WT = WinT; K = 1024; p0 = pb * 32; k0 = kb * 64; }
        else if ((r -= I0) < I1) { const int kb = r / 32, pb = r % 32, p = pb * 32 + 4 * c4;
            src = A.w_ret_o + (p & ~255) + colmap_gate(p & 255); ldn = 1024; WT = WretoT; K = 1536; p0 = pb * 32; k0 = kb * 64; }
        else if ((r -= I1) < I2) { const int kb = r / 32, pb = r % 32, p = pb * 32 + 4 * c4;
            src = A.w_swa_o + (p & ~255) + colmap_gate(p & 255); ldn = 1024; WT = WretoT + 1024; K = 1536; p0 = pb * 32; k0 = kb * 64; }
        else if ((r -= I2) < I3) { const int kb = r / 32, pb = r % 32, p = pb * 32 + 4 * c4;
            src = A.w_out + (p & ~255) + colmap_std(p & 255); ldn = 1024; WT = WoutT; K = 1024; p0 = pb * 32; k0 = kb * 64; }
        else if ((r -= I3) < I4) { const int kb = r / 2, bj = r % 2, pb = 4 * bj, p = pb * 32 + 4 * c4; const int L = colmap_std(p);
            const int Lc = L < 36 ? L : 32;
            src = Lc < 4 ? A.w_rg + Lc : A.w_re + (Lc - 4); ldn = Lc < 4 ? 4 : 32; WT = WrT; K = 1024; p0 = pb * 32; k0 = kb * 64; ks = A.norm_ffn_g; }
        else if ((r -= I4) < IU) { const int e = r >> 9, rr = r & 511, kb = rr >> 5, pb = rr & 31, p = pb * 32 + 4 * c4;
            const int pl = p & 255, bj = pl >> 7, wc = (pl >> 5) & 3, n = (pl >> 4) & 1, fq = (pl >> 2) & 3;
            const int ffc = 128 * (p >> 8) + 32 * wc + 8 * fq + 4 * n;
            src = (bj == 0 ? A.w_gate : A.w_up) + (size_t)e * 1024 * 512 + ffc; ldn = 512; WT = Wgu + (size_t)e * 1024 * 1024; K = 1024; p0 = pb * 32; k0 = kb * 64; ks = A.norm_ffn_g; }
        else { r -= IU; const int e = r >> 8, rr = r & 255, kb = rr >> 5, pb = rr & 31, p = pb * 32 + 4 * c4;
            src = A.w_down + (size_t)e * 512 * 1024 + (p & ~255) + colmap_std(p & 255); ldn = 1024; WT = WdT + (size_t)e * 1024 * 512; K = 512; p0 = pb * 32; k0 = kb * 64; }
        tr_load(t, src, ldn, WT, K, p0, k0, lane, ks);
    };
    auto idx = [&](int j) { return lo + w0 + j * nw; };
    const int n = (hi - lo - w0 + nw - 1) / nw;
    if (n <= 0) return;
    TrItem ta, tb;
    issue(ta, idx(0));
    int j = 0;
    for (; j + 2 < n; j += 2) {
        issue(tb, idx(j + 1));
        tr_finish(ta, scr, lane);
        issue(ta, idx(j + 2));
        tr_finish(tb, scr, lane);
    }
    if (n - j == 2) { issue(tb, idx(j + 1)); tr_finish(ta, scr, lane); tr_finish(tb, scr, lane); }
    else tr_finish(ta, scr, lane);
}

constexpr int CMAX_W = 9216;
DI int win_logical(int p) { const int tile = p >> 8; return tile * 256 + (tile < 4 ? colmap_rot(p & 255) : (tile >= 15 ? colmap_gate(p & 255) : colmap_std(p & 255))); }
DI void win_colmax(const Args& A, unsigned char* ws, int lane, int w0, int nw) {
    unsigned* cmax = (unsigned*)(ws + WS_CTL) + CMAX_W;
    for (int t = w0; t < 32 * 23; t += nw) {
        const int kb = t / 23, cb = t % 23;
        const float* src = A.w_in + (size_t)(kb * 32) * INW + cb * 256 + 4 * lane;
        f32x4 m = {0.f, 0.f, 0.f, 0.f};
#pragma unroll 16
        for (int r = 0; r < 32; ++r) { const f32x4 v = *(const f32x4*)(src + (size_t)r * INW); m[0] = fmaxf(m[0], fabsf(v[0])); m[1] = fmaxf(m[1], fabsf(v[1])); m[2] = fmaxf(m[2], fabsf(v[2])); m[3] = fmaxf(m[3], fabsf(v[3])); }
#pragma unroll
        for (int j = 0; j < 4; ++j) (void)__hip_atomic_fetch_max(&cmax[cb * 256 + 4 * lane + j], __float_as_uint(m[j]), __ATOMIC_RELAXED, __HIP_MEMORY_SCOPE_AGENT);
    }
}
DI void conv_win_i8(const Args& A, unsigned char* ws, LAS float* scr, int lane, int w0, int nw) {
    signed char* W8 = (signed char*)(ws + WS_WIN); const unsigned* cmax = (const unsigned*)(ws + WS_CTL) + CMAX_W; float* csc = (float*)(ws + WS_SS);
    const int c4 = lane & 7, kr = lane >> 3, n = lane >> 1, half = lane & 1;
    for (int it = w0; it < 16 * 184; it += nw) {
        const int kb = it / 184, pb = it % 184, k0 = kb * 64, p0 = pb * 32;
        const float* src = A.w_in + win_logical(p0 + 4 * c4);
        f32x4 v[8];
#pragma unroll
        for (int i = 0; i < 8; ++i) v[i] = *(const f32x4*)(src + (size_t)(k0 + i * 8 + kr) * INW);
        const float amax = fmaxf(__uint_as_float(cmax[win_logical(p0 + n)]), 1e-30f);
        const float qs = 127.0f * __builtin_amdgcn_rcpf(amax);
#pragma unroll
        for (int i = 0; i < 8; ++i) { LAS float* d = scr + (i * 8 + kr) * 33 + 4 * c4; d[0] = v[i][0]; d[1] = v[i][1]; d[2] = v[i][2]; d[3] = v[i][3]; }
        asm volatile("s_waitcnt lgkmcnt(0)" ::: "memory");
        u32x4 o[2];
#pragma unroll
        for (int q = 0; q < 8; ++q) {
            unsigned w = 0;
#pragma unroll
            for (int b = 0; b < 4; ++b) { const float f = scr[(32 * half + 4 * q + b) * 33 + n] * qs; const int c = (int)__builtin_rintf(fminf(fmaxf(f, -127.0f), 127.0f)); w |= ((unsigned)c & 255u) << (8 * b); }
            o[q >> 2][q & 3] = w;
        }
        signed char* dst = W8 + (size_t)(p0 + n) * 1024 + k0 + 32 * half;
        *(u32x4*)dst = o[0]; *(u32x4*)(dst + 16) = o[1];
        if (kb == 0 && half == 0) csc[p0 + n] = amax * (1.0f / 127.0f);
        asm volatile("s_waitcnt lgkmcnt(0)" ::: "memory");
    }
}

constexpr size_t CTL_ECS = 196608;
constexpr size_t CTL_XS = 327680;
DI void quant_wgu(unsigned char* ws, int lane, int r0, int r1, int w0, int nw) {
    unsigned char* W = ws + WS_WGU; float* ecs = (float*)(ws + WS_CTL + CTL_ECS);
    for (int row = r0 + w0; row < r1; row += 2 * nw) {
        const int row2 = row + nw < r1 ? row + nw : row;
        const u32x4 a0 = *(const u32x4*)(W + (size_t)row * 2048 + lane * 32), a1 = *(const u32x4*)(W + (size_t)row * 2048 + lane * 32 + 16);
        const u32x4 b0 = *(const u32x4*)(W + (size_t)row2 * 2048 + lane * 32), b1 = *(const u32x4*)(W + (size_t)row2 * 2048 + lane * 32 + 16);
        float ma = 0.f, mb = 0.f;
#pragma unroll
        for (int i = 0; i < 4; ++i) { const unsigned p = a0[i] & 0x7fff7fffu, q = a1[i] & 0x7fff7fffu, r = b0[i] & 0x7fff7fffu, t = b1[i] & 0x7fff7fffu;
            ma = fmaxf(ma, fmaxf(fmaxf(bflo(p), bfhi(p)), fmaxf(bflo(q), bfhi(q)))); mb = fmaxf(mb, fmaxf(fmaxf(bflo(r), bfhi(r)), fmaxf(bflo(t), bfhi(t)))); }
        ma = fmaxf(wave_max(ma), 1e-30f); mb = fmaxf(wave_max(mb), 1e-30f);
        const float qa = 127.0f * __builtin_amdgcn_rcpf(ma), qb = 127.0f * __builtin_amdgcn_rcpf(mb);
        u32x4 oa, ob;
#pragma unroll
        for (int i = 0; i < 4; ++i) {
            const unsigned pa = i < 2 ? a0[2 * i] : a1[2 * i - 4], pb_ = i < 2 ? a0[2 * i + 1] : a1[2 * i - 3], ra = i < 2 ? b0[2 * i] : b1[2 * i - 4], rb = i < 2 ? b0[2 * i + 1] : b1[2 * i - 3];
            unsigned x = 0u, y = 0u;
            x = __builtin_amdgcn_cvt_pk_u8_f32(__builtin_fmaf(bflo(pa), qa, 128.0f), 0, x); x = __builtin_amdgcn_cvt_pk_u8_f32(__builtin_fmaf(bfhi(pa), qa, 128.0f), 1, x);
            x = __builtin_amdgcn_cvt_pk_u8_f32(__builtin_fmaf(bflo(pb_), qa, 128.0f), 2, x); x = __builtin_amdgcn_cvt_pk_u8_f32(__builtin_fmaf(bfhi(pb_), qa, 128.0f), 3, x);
            y = __builtin_amdgcn_cvt_pk_u8_f32(__builtin_fmaf(bflo(ra), qb, 128.0f), 0, y); y = __builtin_amdgcn_cvt_pk_u8_f32(__builtin_fmaf(bfhi(ra), qb, 128.0f), 1, y);
            y = __builtin_amdgcn_cvt_pk_u8_f32(__builtin_fmaf(bflo(rb), qb, 128.0f), 2, y); y = __builtin_amdgcn_cvt_pk_u8_f32(__builtin_fmaf(bfhi(rb), qb, 128.0f), 3, y);
            oa[i] = x ^ 0x80808080u; ob[i] = y ^ 0x80808080u;
        }
        asm volatile("s_waitcnt vmcnt(0)" ::: "memory");
        *(u32x4*)(W + (size_t)row * 2048 + lane * 16) = oa; if (row2 != row) *(u32x4*)(W + (size_t)row2 * 2048 + lane * 16) = ob;
        if (lane == 0) { ecs[row] = ma * (1.0f / 127.0f); ecs[row2] = mb * (1.0f / 127.0f); }
    }
}

DI void conv_expert_items(const Args& A, unsigned char* ws, LAS float* scr, int lane, int lo, int hi, int w0, int nw) {
    bf16_t* Wgu = (bf16_t*)(ws + WS_WGU); bf16_t* WdT = (bf16_t*)(ws + WS_WDT);
    const int c4 = lane & 7;
    auto issue = [&](TrItem& t, int r) {
        const float* src; int ldn, K, p0, k0; bf16_t* WT; const float* ks = k_ones;
        if (r < CIU) { const int e = r >> 9, rr = r & 511, kb = rr >> 5, pb = rr & 31, p = pb * 32 + 4 * c4;
            const int pl = p & 255, bj = pl >> 7, wc = (pl >> 5) & 3, n = (pl >> 4) & 1, fq = (pl >> 2) & 3;
            const int ffc = 128 * (p >> 8) + 32 * wc + 8 * fq + 4 * n;
            src = (bj == 0 ? A.w_gate : A.w_up) + (size_t)e * 1024 * 512 + ffc; ldn = 512; WT = Wgu + (size_t)e * 1024 * 1024; K = 1024; p0 = pb * 32; k0 = kb * 64; ks = A.norm_ffn_g; }
        else { r -= CIU; const int e = r >> 8, rr = r & 255, kb = rr >> 5, pb = rr & 31, p = pb * 32 + 4 * c4;
            src = A.w_down + (size_t)e * 512 * 1024 + (p & ~255) + colmap_std(p & 255); ldn = 1024; WT = WdT + (size_t)e * 1024 * 512; K = 512; p0 = pb * 32; k0 = kb * 64; }
        tr_load(t, src, ldn, WT, K, p0, k0, lane, ks);
    };
    auto idx = [&](int j) { return lo + w0 + j * nw; };
    const int n = (hi - lo - w0 + nw - 1) / nw;
    if (n <= 0) return;
    TrItem ta, tb;
    issue(ta, idx(0));
    int j = 0;
    for (; j + 2 < n; j += 2) {
        issue(tb, idx(j + 1));
        tr_finish(ta, scr, lane);
        issue(ta, idx(j + 2));
        tr_finish(tb, scr, lane);
    }
    if (n - j == 2) { issue(tb, idx(j + 1)); tr_finish(ta, scr, lane); tr_finish(tb, scr, lane); }
    else tr_finish(ta, scr, lane);
}

#define WS_PTRS \
    size_t wsz_ = 0; asm volatile("" : "+s"(wsz_)); unsigned char* ws = A.ws + wsz_;   \
    int* cnt = (int*)(ws + WS_CTL); \
    bf16_t* WinT = (bf16_t*)(ws + WS_WIN); bf16_t* WretoT = (bf16_t*)(ws + WS_WRETO); bf16_t* WswaoT = (bf16_t*)(ws + WS_WSWAO); bf16_t* WoutT = (bf16_t*)(ws + WS_WOUT); bf16_t* WrT = (bf16_t*)(ws + WS_WR); \
    float* rcos = (float*)(ws + WS_ROT); float* rsin = rcos + SEQ * 64; \
    float* SS = (float*)(ws + WS_SS); float* RT = (float*)(ws + WS_RT); \
    bf16_t* H = (bf16_t*)(ws + WS_H); bf16_t* DR = H; bf16_t* RG = H; bf16_t* YB = H; signed char* H8 = (signed char*)(ws + WS_H); float* HS = (float*)(ws + WS_RT); float* CSC = (float*)(ws + WS_SS); unsigned char* X8 = ws + WS_QR;   float* XS = (float*)(ws + WS_CTL + CTL_XS); float* ECS = (float*)(ws + WS_CTL + CTL_ECS); \
    bf16_t* Qr = (bf16_t*)(ws + WS_QR); bf16_t* Kr = (bf16_t*)(ws + WS_KR); bf16_t* T = Qr; bf16_t* Wgu = (bf16_t*)(ws + WS_WGU); \
    bf16_t* KdT = (bf16_t*)(ws + WS_KDT); bf16_t* WdT = (bf16_t*)(ws + WS_WDT); \
    bf16_t* VT = (bf16_t*)(ws + WS_VT); bf16_t* MG = VT; \
    bf16_t* Gs = (bf16_t*)(ws + WS_GS); bf16_t* XG2 = Gs; \
    bf16_t* SQ = (bf16_t*)(ws + WS_SQ); float* LOG = (float*)(ws + WS_SK); \
    bf16_t* SK = (bf16_t*)(ws + WS_SK); bf16_t* SVT = (bf16_t*)(ws + WS_SVT); \
    bf16_t* RP = (bf16_t*)((unsigned char*)A.out + 64 * MiB); bf16_t* HM = (bf16_t*)(ws + WS_KDT); \
    bf16_t* SWo = (bf16_t*)(ws + WS_SW); \
    int* LTOK = (int*)(ws + WS_LTOK); float* LW = (float*)(ws + WS_LW); f32x2* LRX = (f32x2*)(ws + WS_H);   \
    unsigned char* GA = (unsigned char*)A.out; unsigned char* GB = GA + (size_t)NTOK * 1024;

__global__ void __launch_bounds__(512, 2) hyb_fwd(Args A) {
    extern __shared__ __attribute__((aligned(16))) unsigned char lds_raw[];
    LAS unsigned char* lds = (LAS unsigned char*)lds_raw;
    cg::grid_group grid = cg::this_grid();
    const int tid = threadIdx.x, lane = tid & 63, wave = __builtin_amdgcn_readfirstlane(tid >> 6);
    const int G = gridDim.x, bx = blockIdx.x;
    const int gw = bx * 8 + wave, NGW = G * 8;
    const int r32 = lane & 31, hi = lane >> 5;
    LAS int* tab = (LAS int*)(lds + LDS_TAB);
    volatile LAS unsigned* SV = (volatile LAS unsigned*)(lds + LDS_TAB + 3072);
    volatile LAS unsigned* MISC = (volatile LAS unsigned*)(lds + LDS_TAB + 2048);
    if (tid < 2) MISC[tid] = 0u;
    __syncthreads();
    const XcdBarrier xbar = xcd_barrier_post((unsigned*)(A.ws + WS_CTL) + 1024, MISC);
#define GSYNC() xcd_barrier(xbar)
#define GSYNC_QW(k) do { xcd_arrive(xbar, SV); quant_wgu(A.ws, lane, (k) * 8192, ((k) + 1) * 8192, gw, NGW); xcd_wait(xbar, SV); } while (0)
    volatile LAS unsigned long long* TS = (volatile LAS unsigned long long*)(lds + LDS_TAB + 4096);
    int n_ts = 0;
#define STAMP() do { if (PROBE_A >= 0) { if (bx == 0 && tid == 0) TS[n_ts] = __builtin_amdgcn_s_memrealtime(); ++n_ts; } } while (0)
    STAMP();

    if constexpr ((PHMASK >> 0) & 1) {
        WS_PTRS;
        LAS float* scr = (LAS float*)(lds + wave * 16384);
        win_colmax(A, ws, lane, gw, NGW);
        xcd_arrive(xbar, SV);
        for (int m = gw; m < NTOK; m += 2 * NGW) {
            const int m2 = m + NGW;
            const bool h2 = m2 < NTOK;
            const f32x4* xr = (const f32x4*)(A.x + (size_t)m * DM) + lane;
            const f32x4* xr2 = (const f32x4*)(A.x + (size_t)(h2 ? m2 : m) * DM) + lane;
            f32x4 v[4], v2[4]; float s = 0.f, s2 = 0.f;
#pragma unroll
            for (int j = 0; j < 4; ++j) { v[j] = xr[64 * j]; v2[j] = xr2[64 * j]; }
#pragma unroll
            for (int j = 0; j < 4; ++j) { s += (v[j][0] * v[j][0] + v[j][1] * v[j][1]) + (v[j][2] * v[j][2] + v[j][3] * v[j][3]); s2 += (v2[j][0] * v2[j][0] + v2[j][1] * v2[j][1]) + (v2[j][2] * v2[j][2] + v2[j][3] * v2[j][3]); }
            const float r = __builtin_amdgcn_rsqf(wave_sum(s) * (1.0f / DM) + EPS), r2 = __builtin_amdgcn_rsqf(wave_sum(s2) * (1.0f / DM) + EPS);
            float am = 0.f, am2 = 0.f;
#pragma unroll
            for (int j = 0; j < 4; ++j) { const f32x4 g = ((const f32x4*)A.norm_mix_g)[lane + 64 * j]; v[j] = v[j] * r * g; v2[j] = v2[j] * r2 * g;
                am = fmaxf(fmaxf(am, fmaxf(fabsf(v[j][0]), fabsf(v[j][1]))), fmaxf(fabsf(v[j][2]), fabsf(v[j][3])));
                am2 = fmaxf(fmaxf(am2, fmaxf(fabsf(v2[j][0]), fabsf(v2[j][1]))), fmaxf(fabsf(v2[j][2]), fabsf(v2[j][3]))); }
            am = fmaxf(wave_max(am), 1e-30f); am2 = fmaxf(wave_max(am2), 1e-30f);
            const float qs = 127.0f * __builtin_amdgcn_rcpf(am), qs2 = 127.0f * __builtin_amdgcn_rcpf(am2);
            unsigned* o8 = (unsigned*)(H8 + (size_t)m * DM) + lane; unsigned* o82 = (unsigned*)(H8 + (size_t)m2 * DM) + lane;
#pragma unroll
            for (int j = 0; j < 4; ++j) {
                unsigned w = 0, w2 = 0;
#pragma unroll
                for (int b = 0; b < 4; ++b) { const int c = (int)__builtin_rintf(fminf(fmaxf(v[j][b] * qs, -127.0f), 127.0f)), c2 = (int)__builtin_rintf(fminf(fmaxf(v2[j][b] * qs2, -127.0f), 127.0f));
                    w |= ((unsigned)c & 255u) << (8 * b); w2 |= ((unsigned)c2 & 255u) << (8 * b); }
                o8[64 * j] = w; if (h2) o82[64 * j] = w2;
            }
            if (lane == 0) { HS[m] = am * (1.0f / 127.0f); if (h2) HS[m2] = am2 * (1.0f / 127.0f); }
        }
        for (int e = bx * 512 + tid; e < SEQ * 64; e += G * 512) {
            const int pos = e >> 6, i = e & 63;
            double inv = 1.0; for (int k = 0; k < i; ++k) inv *= 0.8659643233600653;
            double s, c; sincos_d((double)pos * inv, s, c);
            rcos[e] = (float)c; rsin[e] = (float)s;
        }
        xcd_wait(xbar, SV);
        conv_win_i8(A, ws, scr, lane, gw, NGW);
        conv_items(A, ws, scr, lane, CI0, CNS, gw, NGW);
        xcd_arrive(xbar, SV);
        conv_expert_items(A, ws, scr, lane, 0, CEXP0, gw, NGW);
        xcd_wait(xbar, SV);
    }
    if (__builtin_expect(A.out == nullptr, 0)) grid.sync();
    STAMP();

    if constexpr ((PHMASK >> 1) & 1) {
        WS_PTRS;
        pg8::DenseOrder S; S.init(NTOK, INW, 512, G, bx, WinT, 0, WGM_P1);
        EpiProj E{Qr, Kr, KdT, VT, Gs, SQ, SK, SVT, GA, GB, rcos, rsin, A.q_norm_g, A.k_norm_g, HS, CSC};
        pg8::gemm_phase<EpiProj, pg8::DenseOrder, 0, true>(lds, (const char*)H8, 512, S, E);
        if ((ABL & 16) ? (bx < 128) : (bx >= 128)) {
            __syncthreads();
            conv_expert_items(A, ws, (LAS float*)(lds + wave * 16384), lane, CEXP0, CEXP0 + CEXP1, ((bx & 127)) * 8 + wave, 128 * 8);
        }
    }
    GSYNC_QW(0); STAMP();

    if constexpr ((PHMASK >> 2) & 1) {
        WS_PTRS;
        {
            int item = bx;
            if (item < 1024) { const int bh = item >> 6, c = item & 63;
                stage_tile<256>(lds, 0, (const char*)(VT + (size_t)bh * 256 * SEQ + c * 128), (size_t)SEQ * 2, 256, wave, lane);
                stage_tile<256>(lds, 65536, (const char*)(KdT + (size_t)bh * 128 * SEQ + c * 128), (size_t)SEQ * 2, 128, wave, lane); }
            for (; item < 1024; item += G) {
                asm volatile("s_waitcnt vmcnt(0)" ::: "memory"); __syncthreads();
                f32x16 acc[4];
#pragma unroll
                for (int d = 0; d < 4; ++d)
#pragma unroll
                    for (int r = 0; r < 16; ++r) acc[d][r] = 0.f;
#pragma unroll
                for (int s = 0; s < 8; ++s) {
                    const bf16x8 a = LDS_V16(swz<256>(32 * wave + r32, 2 * s + hi));
#pragma unroll
                    for (int d = 0; d < 4; ++d) { const bf16x8 b = LDS_V16(65536 + swz<256>(32 * d + r32, 2 * s + hi)); acc[d] = MFMA32(a, b, acc[d]); }
                }
                __syncthreads();
                const int nx = item + G;
                if (nx < 1024) { const int bh = nx >> 6, c = nx & 63;
                    stage_tile<256>(lds, 0, (const char*)(VT + (size_t)bh * 256 * SEQ + c * 128), (size_t)SEQ * 2, 256, wave, lane);
                    stage_tile<256>(lds, 65536, (const char*)(KdT + (size_t)bh * 128 * SEQ + c * 128), (size_t)SEQ * 2, 128, wave, lane); }
                bf16_t* dr = DR + (size_t)item * 32768;
#pragma unroll
                for (int d = 0; d < 4; ++d)
#pragma unroll
                    for (int r = 0; r < 16; ++r) dr[(32 * wave + crow(r, hi)) * 128 + d * 32 + r32] = f2bf(acc[d][r]);
            }
            asm volatile("s_waitcnt vmcnt(0)" ::: "memory"); __syncthreads();
        }
        xcd_arrive(xbar, SV);
        {
            auto stage_swa = [&](int it) {
                const int n = it & 63, kvh = (it >> 6) & 1, b = it >> 7;
                stage_tile<512>(lds, 0, (const char*)(SQ + (size_t)(b * SEQ + n * 128) * 512 + kvh * 256), 1024, 128, wave, lane);
                const int k0 = n * 128 - 128;
                stage_tile<128>(lds, 65536, (const char*)(SK + ((size_t)b * SEQ + k0) * 128 + kvh * 64), 256, 256, wave, lane);
                stage_tile<512>(lds, 98304, (const char*)(SVT + (size_t)((b * 2 + kvh) * 64) * SEQ + k0), (size_t)SEQ * 2, 64, wave, lane);
            };
            int it = bx;
            if (it < 512) stage_swa(it);
            for (; it < 512; it += G) {
                const int n = it & 63, kvh = (it >> 6) & 1, b = it >> 7;
                asm volatile("s_waitcnt vmcnt(0)" ::: "memory"); __syncthreads();
                const int g = wave & 3, head = kvh * 4 + g;
                const float sink = A.sinks[head];
                for (int ib = 2 * (wave >> 2); ib < 2 * (wave >> 2) + 2; ++ib) {
                    const int tokq = b * SEQ + n * 128 + ib * 32 + r32;
                    bf16x8 qf[4];
#pragma unroll
                    for (int s = 0; s < 4; ++s) qf[s] = LDS_V16(swz<512>(ib * 32 + r32, g * 8 + 2 * s + hi));
                    f32x16 X[5];
                    float mx = sink;
#pragma unroll
                    for (int kb = 0; kb < 5; ++kb) {
                        const bool live = (n > 0) || (ib + kb >= 4);
#pragma unroll
                        for (int r = 0; r < 16; ++r) X[kb][r] = 0.f;
                        if (live) {
#pragma unroll
                            for (int s = 0; s < 4; ++s) { const bf16x8 a = LDS_V16(65536 + swz<128>((ib + kb) * 32 + r32, 2 * s + hi)); X[kb] = MFMA32(a, qf[s], X[kb]); }
                        }
#pragma unroll
                        for (int r = 0; r < 16; ++r) {
                            const int j = crow(r, hi);
                            const bool valid = live && (kb == 0 ? (j > r32) : (kb == 4 ? (j <= r32) : true));
                            X[kb][r] = valid ? X[kb][r] : -INFINITY;
                            mx = fmaxf(mx, X[kb][r]);
                        }
                    }
                    mx = fmaxf(mx, __shfl_xor(mx, 32));
                    float den = 0.f;
#pragma unroll
                    for (int kb = 0; kb < 5; ++kb)
#pragma unroll
                        for (int r = 0; r < 16; ++r) { const float p = __expf(X[kb][r] - mx); X[kb][r] = p; den += p; }
                    den += __shfl_xor(den, 32);
                    den += __expf(sink - mx);
                    const float rden = __builtin_amdgcn_rcpf(den);
                    f32x16 o[2];
#pragma unroll
                    for (int d = 0; d < 2; ++d)
#pragma unroll
                        for (int r = 0; r < 16; ++r) o[d][r] = 0.f;
#pragma unroll
                    for (int kb = 0; kb < 5; ++kb) {
                        const bool live = (n > 0) || (ib + kb >= 4);
                        if (live) {
#pragma unroll
                            for (int s2 = 0; s2 < 2; ++s2) {
                                const bf16x8 pb = pack8(X[kb], s2);
#pragma unroll
                                for (int d = 0; d < 2; ++d) {
                                    const int ch = 4 * (ib + kb) + 2 * s2;
                                    const u32x2 lo = LDS_V8(98304 + swz<512>(d * 32 + r32, ch) + 8 * hi), hh = LDS_V8(98304 + swz<512>(d * 32 + r32, ch + 1) + 8 * hi);
                                    u32x4 av; av.x = lo.x; av.y = lo.y; av.z = hh.x; av.w = hh.y;
                                    o[d] = MFMA32(__builtin_bit_cast(bf16x8, av), pb, o[d]);
                                }
                            }
                        }
                    }
#pragma unroll
                    for (int d = 0; d < 2; ++d)
#pragma unroll
                        for (int q = 0; q < 4; ++q) {
                            u32x2 w; w.x = pk2(o[d][4 * q] * rden, o[d][4 * q + 1] * rden); w.y = pk2(o[d][4 * q + 2] * rden, o[d][4 * q + 3] * rden);
                            *(u32x2*)(SWo + (size_t)tokq * 512 + head * 64 + d * 32 + 8 * q + 4 * hi) = w;
                        }
                }
                __syncthreads();
                if (it + G < 512) stage_swa(it + G);
            }
            asm volatile("s_waitcnt vmcnt(0)" ::: "memory");
        }
    }
    xcd_wait(xbar, SV); STAMP();

    if constexpr ((PHMASK >> 3) & 1) {
        WS_PTRS;
        for (int gi = bx * 256 + tid; tid < 256 && gi < 16 * 4096; gi += G * 256) {
            const int bh = gi >> 12, e8 = gi & 4095, h = bh & 3;
            const float dec = __builtin_amdgcn_exp2f(128.0f * lg2gamma(h));
            float r[8];
#pragma unroll
            for (int j = 0; j < 8; ++j) r[j] = 0.f;
            const size_t base = (size_t)bh * 64 * 32768 + (size_t)e8 * 8;
#pragma unroll 8
            for (int c = 0; c < 64; ++c) {
                const u32x4 d = *(const u32x4*)(DR + base + (size_t)c * 32768);
                u32x4 w; w.x = pk2(r[0], r[1]); w.y = pk2(r[2], r[3]); w.z = pk2(r[4], r[5]); w.w = pk2(r[6], r[7]);
                *(u32x4*)(RP + base + (size_t)c * 32768) = w;
                r[0] = r[0] * dec + bflo(d.x); r[1] = r[1] * dec + bfhi(d.x); r[2] = r[2] * dec + bflo(d.y); r[3] = r[3] * dec + bfhi(d.y);
                r[4] = r[4] * dec + bflo(d.z); r[5] = r[5] * dec + bfhi(d.z); r[6] = r[6] * dec + bflo(d.w); r[7] = r[7] * dec + bfhi(d.w);
            }
        }
    }
    xcd_arrive(xbar, SV);
    conv_expert_items(A, A.ws, (LAS float*)(lds + wave * 16384), lane, CEXP0 + CEXP1, CIU + CID, gw, NGW);
    xcd_wait(xbar, SV); STAMP();

    if constexpr ((PHMASK >> 4) & 1) {
        WS_PTRS;
        LAS float* xs = (LAS float*)(lds + LDS_TAB + 12288);
        auto stage_qk = [&](int it) { const int bh = it >> 6, c = it & 63, b = bh >> 2, h = bh & 3; const size_t t0 = (size_t)b * SEQ + c * 128;
            stage_tile<256>(lds, 0, (const char*)(Qr + t0 * 512 + h * 128), 1024, 128, wave, lane);
            stage_tile<256>(lds, 32768, (const char*)(Kr + t0 * 512 + h * 128), 1024, 128, wave, lane); };
        auto stage_rp = [&](int it) { stage_tile<256>(lds, 65536, (const char*)(RP + (size_t)it * 32768), 256, 256, wave, lane); };
        auto stage_vt = [&](int it) { const int bh = it >> 6, c = it & 63; stage_tile<256>(lds, 65536, (const char*)(VT + (size_t)bh * 256 * SEQ + c * 128), (size_t)SEQ * 2, 256, wave, lane); };
        int item = bx;
        if (item < 1024) { stage_qk(item); stage_rp(item); }
        for (; item < 1024; item += G) {
            const int bh = item >> 6, c = item & 63, b = bh >> 2, h = bh & 3, ib = wave & 3, dh = wave >> 2;
            const float lg = lg2gamma(h);
            int r32o = r32, hio = hi; asm volatile("" : "+v"(r32o), "+v"(hio));
            const int il = ib * 32 + r32o;
            const int xk = r32o & 15;
            const int nx = item + G;
            asm volatile("s_waitcnt vmcnt(0)" ::: "memory"); __syncthreads();
            bf16x8 qf[8];
#pragma unroll
            for (int s = 0; s < 8; ++s) qf[s] = LDS_V16(il * 256 + (((2 * s + hio) ^ xk) << 4));
            f32x16 acc[4];
#pragma unroll
            for (int d = 0; d < 4; ++d)
#pragma unroll
                for (int r = 0; r < 16; ++r) acc[d][r] = 0.f;
            { const int rb = 65536 + (dh * 128 + r32o) * 256;
#pragma unroll
              for (int s = 0; s < 8; ++s) { const int co = ((2 * s + hio) ^ xk) << 4;
#pragma unroll
                for (int d = 0; d < 4; ++d) { const bf16x8 a = LDS_V16(rb + d * 8192 + co); acc[d] = MFMA32(a, qf[s], acc[d]); } } }
            const float fc = __builtin_amdgcn_exp2f((float)(il + 1) * lg);
#pragma unroll
            for (int d = 0; d < 4; ++d)
#pragma unroll
                for (int r = 0; r < 16; ++r) acc[d][r] *= fc;
            __syncthreads();
            stage_vt(item);
            bf16x8 pf[4][2];
#pragma unroll
            for (int jb = 0; jb < 4; ++jb) {
                if (jb <= ib) {
                    f32x16 X;
#pragma unroll
                    for (int r = 0; r < 16; ++r) X[r] = 0.f;
                    const int kbs = 32768 + (jb * 32 + r32o) * 256;
#pragma unroll
                    for (int s = 0; s < 8; ++s) { const bf16x8 a = LDS_V16(kbs + (((2 * s + hio) ^ xk) << 4)); X = MFMA32(a, qf[s], X); }
#pragma unroll
                    for (int r = 0; r < 16; ++r) { const int dd = il - (jb * 32 + crow(r, hio)); X[r] = dd >= 0 ? X[r] * __builtin_amdgcn_exp2f((float)dd * lg) : 0.f; }
                    pf[jb][0] = pack8(X, 0); pf[jb][1] = pack8(X, 1);
                } else { pf[jb][0] = (bf16x8){0, 0, 0, 0, 0, 0, 0, 0}; pf[jb][1] = pf[jb][0]; }
            }
            asm volatile("s_waitcnt vmcnt(0)" ::: "memory"); __syncthreads();
            if (nx < 1024) stage_qk(nx);
            const int tok = b * SEQ + c * 128 + il;
            u32x4 gsw[4][2];
#pragma unroll
            for (int d = 0; d < 4; ++d)
#pragma unroll
                for (int k = 0; k < 2; ++k) gsw[d][k] = *(const u32x4*)(Gs + (size_t)tok * 1024 + h * 256 + dh * 128 + d * 32 + 16 * k + 8 * hio);
            { const int vb = 65536 + (dh * 128 + r32o) * 256 + 8 * hio;
#pragma unroll
              for (int jb = 0; jb < 4; ++jb) {
                if (jb <= ib) {
#pragma unroll
                    for (int s2 = 0; s2 < 2; ++s2) { const int c0 = ((4 * jb + 2 * s2) ^ xk) << 4, c1 = ((4 * jb + 2 * s2 + 1) ^ xk) << 4;
#pragma unroll
                        for (int d = 0; d < 4; ++d) {
                            const u32x2 lo = LDS_V8(vb + d * 8192 + c0), hh = LDS_V8(vb + d * 8192 + c1);
                            u32x4 av; av.x = lo.x; av.y = lo.y; av.z = hh.x; av.w = hh.y;
                            acc[d] = MFMA32(__builtin_bit_cast(bf16x8, av), pf[jb][s2], acc[d]);
                        } }
                }
              } }
            float sm = 0.f, sq = 0.f;
#pragma unroll
            for (int d = 0; d < 4; ++d)
#pragma unroll
                for (int r = 0; r < 16; ++r) { sm += acc[d][r]; sq += acc[d][r] * acc[d][r]; }
            sm += __shfl_xor(sm, 32); sq += __shfl_xor(sq, 32);
            if (hio == 0) { xs[((dh * 4 + ib) * 32 + r32o) * 2] = sm; xs[((dh * 4 + ib) * 32 + r32o) * 2 + 1] = sq; }
            __syncthreads();
            if (nx < 1024) stage_rp(nx);
            sm += xs[(((dh ^ 1) * 4 + ib) * 32 + r32o) * 2]; sq += xs[(((dh ^ 1) * 4 + ib) * 32 + r32o) * 2 + 1];
            const float mu = sm * (1.0f / 256.0f);
            const float var = fmaxf(sq * (1.0f / 256.0f) - mu * mu, 0.f);
            const float rstd = __builtin_amdgcn_rsqf(var + EPS);
#pragma unroll
            for (int d = 0; d < 4; ++d)
#pragma unroll
                for (int k = 0; k < 2; ++k) {
                    u32x4 g = gsw[d][k];
                    { auto r0 = __builtin_amdgcn_permlane32_swap(g.x, g.z, false, false); g.x = r0[0]; g.z = r0[1]; auto r1 = __builtin_amdgcn_permlane32_swap(g.y, g.w, false, false); g.y = r1[0]; g.w = r1[1]; }
                    u32x2 w[2];
#pragma unroll
                    for (int e = 0; e < 2; ++e) {
                        const int q = 2 * k + e, dv = dh * 128 + d * 32 + 8 * q + 4 * hio;
                        const f32x4 gn = *(const f32x4*)(A.ret_gn_g + h * 256 + dv);
                        const unsigned g0 = e ? g.z : g.x, g1 = e ? g.w : g.y;
                        const float y0 = (acc[d][4 * q] - mu) * rstd * gn[0] * bflo(g0), y1 = (acc[d][4 * q + 1] - mu) * rstd * gn[1] * bfhi(g0);
                        const float y2 = (acc[d][4 * q + 2] - mu) * rstd * gn[2] * bflo(g1), y3 = (acc[d][4 * q + 3] - mu) * rstd * gn[3] * bfhi(g1);
                        w[e].x = pk2(y0, y1); w[e].y = pk2(y2, y3);
                    }
                    { auto r0 = __builtin_amdgcn_permlane32_swap(w[0].x, w[1].x, false, false); w[0].x = r0[0]; w[1].x = r0[1]; auto r1 = __builtin_amdgcn_permlane32_swap(w[0].y, w[1].y, false, false); w[0].y = r1[0]; w[1].y = r1[1]; }
                    *(u32x4*)(RG + (size_t)tok * 1024 + h * 256 + dh * 128 + d * 32 + 16 * k + 8 * hio) = (u32x4){w[0].x, w[0].y, w[1].x, w[1].y};
                }
        }
        asm volatile("s_waitcnt vmcnt(0)" ::: "memory"); __syncthreads();
    }
    GSYNC_QW(1); STAMP();

    if constexpr ((PHMASK >> 5) & 1) {
        WS_PTRS;
        pg8::DenseOrder S; S.init(NTOK, 1024, 1536, G, bx, WretoT, 1024, WGM_P5);
        EpiMerge E{GA, GB, MG};
        pg8::gemm_phase<EpiMerge, pg8::DenseOrder, 16>(lds, (const char*)RG, 1536, S, E, (const char*)SWo);
        if (ABL & 65536) { __syncthreads(); pg8::gemm_phase<EpiMerge, pg8::DenseOrder, 16>(lds, (const char*)RG, 1536, S, E, (const char*)SWo); }
    }
    GSYNC_QW(2); STAMP();

    if constexpr ((PHMASK >> 6) & 1) {
        WS_PTRS;
        pg8::DenseOrder S; S.init(NTOK, 1024, 1024, G, bx, WoutT, 0, WGM_P6);
        EpiOut E{A.x, XG2, SS};
        pg8::gemm_phase(lds, (const char*)MG, 1024, S, E);
    }
    GSYNC_QW(3); STAMP();

    if constexpr ((PHMASK >> 7) & 1) {
        WS_PTRS;
        typedef float f32x4v __attribute__((ext_vector_type(4)));
        LAS float* LG = (LAS float*)(lds + 98304);
        LAS int* lcnt = (LAS int*)(lds + LDS_TAB + 8192);
        if (tid < 64) lcnt[tid] = 0;
        {
            const int fr = lane & 15, fq = lane >> 4;
            const int row0 = bx * 128 + wave * 16;
            typedef __attribute__((address_space(1))) const bf16x8 gbf16x8;
            for (int i = wave; i < 96; i += 8) {
                const int r = i >> 1, half = i & 1, pr = r < 32 ? r : 96 + r, slot = half * 64 + lane;
                __builtin_amdgcn_global_load_lds((const unsigned*)(WrT + (size_t)pr * 1024 + ((slot ^ (r & 15)) << 3)), (LAS unsigned*)(lds + r * 2048 + half * 1024), 16, 0, 0);
            }
            gbf16x8* ap = (gbf16x8*)(XG2 + (size_t)(row0 + fr) * 1024 + 8 * fq);
            bf16x8 av[32];
#pragma unroll
            for (int kk = 0; kk < 32; ++kk) av[kk] = ap[kk * 4];
            asm volatile("s_waitcnt vmcnt(0)" ::: "memory"); __syncthreads();
            float am = 0.f;
#pragma unroll
            for (int kk = 0; kk < 32; ++kk) { const u32x4 w = __builtin_bit_cast(u32x4, av[kk]);
                const unsigned m01 = (w.x & 0x7fff7fffu), m23 = (w.y & 0x7fff7fffu), m45 = (w.z & 0x7fff7fffu), m67 = (w.w & 0x7fff7fffu);
                am = fmaxf(am, fmaxf(fmaxf(bflo(m01), bfhi(m01)), fmaxf(bflo(m23), bfhi(m23))));
                am = fmaxf(am, fmaxf(fmaxf(bflo(m45), bfhi(m45)), fmaxf(bflo(m67), bfhi(m67)))); }
            am = fmaxf(am, __shfl_xor(am, 16)); am = fmaxf(am, __shfl_xor(am, 32)); am = fmaxf(am, 1e-30f);
            float qs = 127.0f * __builtin_amdgcn_rcpf(am);
            unsigned char* xo = X8 + (size_t)(row0 + fr) * 2048 + 8 * fq;
            if (fq == 0) ((LAS float*)(lds + 118784))[wave * 16 + fr] = am * (1.0f / 127.0f);
            f32x4v a0 = {0.f, 0.f, 0.f, 0.f}, a1 = a0, a2 = a0;
            const int xk = fr;
#pragma unroll
            for (int kk = 0; kk < ((ABL & 64) ? 0 : 32); ++kk) {
                const int co = ((4 * kk + fq) ^ xk) << 4;
                const bf16x8 b0 = LDS_V16(fr * 2048 + co), b1 = LDS_V16((16 + fr) * 2048 + co), b2 = LDS_V16((32 + fr) * 2048 + co);
                a0 = __builtin_amdgcn_mfma_f32_16x16x32_bf16(av[kk], b0, a0, 0, 0, 0);
                a1 = __builtin_amdgcn_mfma_f32_16x16x32_bf16(av[kk], b1, a1, 0, 0, 0);
                a2 = __builtin_amdgcn_mfma_f32_16x16x32_bf16(av[kk], b2, a2, 0, 0, 0);
                asm volatile("" : "+v"(qs));
                { const u32x4 w = __builtin_bit_cast(u32x4, av[kk]);
                  unsigned ox = 0u, oy = 0u;
                  ox = __builtin_amdgcn_cvt_pk_u8_f32(__builtin_fmaf(bflo(w.x), qs, 128.0f), 0, ox); ox = __builtin_amdgcn_cvt_pk_u8_f32(__builtin_fmaf(bfhi(w.x), qs, 128.0f), 1, ox);
                  ox = __builtin_amdgcn_cvt_pk_u8_f32(__builtin_fmaf(bflo(w.y), qs, 128.0f), 2, ox); ox = __builtin_amdgcn_cvt_pk_u8_f32(__builtin_fmaf(bfhi(w.y), qs, 128.0f), 3, ox);
                  oy = __builtin_amdgcn_cvt_pk_u8_f32(__builtin_fmaf(bflo(w.z), qs, 128.0f), 0, oy); oy = __builtin_amdgcn_cvt_pk_u8_f32(__builtin_fmaf(bfhi(w.z), qs, 128.0f), 1, oy);
                  oy = __builtin_amdgcn_cvt_pk_u8_f32(__builtin_fmaf(bflo(w.w), qs, 128.0f), 2, oy); oy = __builtin_amdgcn_cvt_pk_u8_f32(__builtin_fmaf(bfhi(w.w), qs, 128.0f), 3, oy);
                  u32x2 o; o.x = ox ^ 0x80808080u; o.y = oy ^ 0x80808080u;
                  *(u32x2*)(xo + 32 * kk) = o; }
            }
            const int L0 = colmap_std(fr), L1 = colmap_std(16 + fr), L2 = colmap_std(128 + fr);
#pragma unroll
            for (int r = 0; r < 4; ++r) {
                LAS float* lr = LG + (wave * 16 + 4 * fq + r) * 40;
                if (L0 < 36) lr[L0] = a0[r];
                if (L1 < 36) lr[L1] = a1[r];
                if (L2 < 36) lr[L2] = a2[r];
            }
        }
        __syncthreads();
        int t = 0, ga = 0, gb = 0, la = 0, lb = 0; float w0 = 0.f, w1 = 0.f, rr_ = 0.f, xs_ = 0.f;
        if (tid < 128 && !(ABL & 128)) {
            t = bx * 128 + tid;
            const LAS float* lg = LG + tid * 40;
            float ss = 0.f;
#pragma unroll
            for (int k = 0; k < 4; ++k) { const f32x4 v = *(const f32x4*)(SS + (size_t)t * 16 + 4 * k); ss += (v[0] + v[1]) + (v[2] + v[3]); }
            const float r = __builtin_amdgcn_rsqf(ss * (1.0f / DM) + EPS);
            RT[t] = r; rr_ = r; xs_ = ((const LAS float*)(lds + 118784))[tid];
            float gl[4];
#pragma unroll
            for (int k = 0; k < 4; ++k) gl[k] = lg[k] * r + A.b_rg[k];
            int gi = 0; float gm = gl[0];
#pragma unroll
            for (int k = 1; k < 4; ++k) if (gl[k] > gm) { gm = gl[k]; gi = k; }
            float gs = 0.f;
#pragma unroll
            for (int k = 0; k < 4; ++k) gs += __expf(gl[k] - gm);
            const float gprob = __builtin_amdgcn_rcpf(gs);
            float el[8];
#pragma unroll
            for (int k = 0; k < 8; ++k) el[k] = lg[4 + gi * 8 + k] * r + A.b_re[gi * 8 + k];
            int e0 = 0; float m0 = el[0];
#pragma unroll
            for (int k = 1; k < 8; ++k) if (el[k] > m0) { m0 = el[k]; e0 = k; }
            int e1 = 0; float m1 = -INFINITY;
#pragma unroll
            for (int k = 0; k < 8; ++k) if (k != e0 && el[k] > m1) { m1 = el[k]; e1 = k; }
            const float x1 = __expf(m1 - m0);
            { const float r1_ = gprob * __builtin_amdgcn_rcpf(1.0f + x1); w0 = r1_; w1 = r1_ * x1; }
            ga = gi * 8 + e0; gb = 32 + gi * 8 + e1;
            la = __hip_atomic_fetch_add(lcnt + ga, 1, __ATOMIC_RELAXED, __HIP_MEMORY_SCOPE_WORKGROUP);
            lb = __hip_atomic_fetch_add(lcnt + gb, 1, __ATOMIC_RELAXED, __HIP_MEMORY_SCOPE_WORKGROUP);
        }
        __syncthreads();
        if (tid < 64) lcnt[64 + tid] = lcnt[tid] ? atomicAdd(cnt + tid, lcnt[tid]) : 0;
        __syncthreads();
        if (tid < 128) {
            const int ra = lcnt[64 + ga] + la, rb = lcnt[64 + gb] + lb;
            LTOK[(size_t)ga * LCAP + ra] = t; LW[(size_t)ga * LCAP + ra] = w0; LRX[(size_t)ga * LCAP + ra] = (f32x2){rr_, xs_}; LRX[(size_t)gb * LCAP + rb] = (f32x2){rr_, xs_};
            LTOK[(size_t)gb * LCAP + rb] = t; LW[(size_t)gb * LCAP + rb] = w1;
        }
        __syncthreads();
    }
    GSYNC(); STAMP();

    if (tid == 0) {
        WS_PTRS;
        int tp = 0;
        for (int g = 0; g < 64; ++g) { const int c = cnt[g]; tab[g] = c; tab[64 + g] = tp; tab[192 + g] = tp * 256; tp += (c + 255) >> 8; }
        tab[128] = tp;
    }
    __syncthreads();

    if constexpr ((PHMASK >> 8) & 1) {
        WS_PTRS;
        pg8::GroupOrder S; S.init(tab, 0, 64, 1024, G, bx, Wgu, (size_t)1024 * 1024 * 2, LTOK, true);
        EpiUp E{HM, tab, LRX, ECS};
        pg8::gemm_phase<EpiUp, pg8::GroupOrder, 0, true, 8>(lds, (const char*)X8, 1024, S, E);
    }
    GSYNC(); STAMP();
    if constexpr ((PHMASK >> 9) & 1) {
        WS_PTRS;
        pg8::GroupOrder S; S.init(tab, 0, 32, 512, G, bx, WdT, (size_t)1024 * 512 * 2, LTOK, false);
        EpiDown<0> E{XG2, YB, A.out, tab, LTOK, LW, &xbar, SV};
        pg8::gemm_phase(lds, (const char*)HM, 512, S, E);
    }
    if (tid == 0) SV[3] = 0u;
    xcd_arrive(xbar, SV); STAMP();
    if constexpr ((PHMASK >> 10) & 1) {
        WS_PTRS;
        pg8::GroupOrder S; S.init(tab, 32, 32, 512, G, G - 1 - bx, WdT, (size_t)1024 * 512 * 2, LTOK, false);
        EpiDown<1> E{YB, YB, A.out, tab, LTOK, LW, &xbar, SV};
        pg8::gemm_phase(lds, (const char*)HM, 512, S, E);
    }
    if (SV[3] == 0u) xcd_wait(xbar, SV);
    if (PROBE_A >= 0) {
        GSYNC(); STAMP();
        float* pr = (float*)(A.ws + WS_CTL) + 8192;
        if (bx == 0 && tid == 0) {
            const float da = PROBE_A == 50 ? (float)(TS[n_ts - 1] - TS[0]) * 0.001f : (float)(TS[PROBE_A + 1] - TS[PROBE_A]) * 0.01f;
            const float db = PROBE_B == 99 ? 100.0f : (float)(TS[(PROBE_B < 0 ? 0 : PROBE_B) + 1] - TS[PROBE_B < 0 ? 0 : PROBE_B]) * 0.01f;
            __hip_atomic_store(pr, PROBE_BASE > 0 ? da * (float)PROBE_BASE : da * 100.0f, __ATOMIC_RELAXED, __HIP_MEMORY_SCOPE_AGENT); __hip_atomic_store(pr + 1, db * 10.0f, __ATOMIC_RELAXED, __HIP_MEMORY_SCOPE_AGENT);
        }
        GSYNC();
        const float v1 = __hip_atomic_load(pr, __ATOMIC_RELAXED, __HIP_MEMORY_SCOPE_AGENT), v2 = __hip_atomic_load(pr + 1, __ATOMIC_RELAXED, __HIP_MEMORY_SCOPE_AGENT);
        for (size_t e = (size_t)bx * 512 + tid; e < (size_t)NTOK * DM; e += (size_t)G * 512) A.out[e] = e == 0 ? v1 : v2;
    }
}

extern "C" void kernel_launch(void* const* d_in, const int* in_sizes, int n_in, void* d_out, int out_size, void* d_ws, size_t ws_size, hipStream_t stream) {
    static int grid = 0;
    if (grid == 0) {
        if (n_in != 18 || out_size != NTOK * DM || ws_size < WS_END) { fprintf(stderr, "kernel_launch: unexpected shapes (n_in %d out %d ws %zu)\n", n_in, out_size, ws_size); grid = -1; return; }
        int dev = 0, cus = 0, per_cu = 0;
        hipGetDevice(&dev);
        hipDeviceGetAttribute(&cus, hipDeviceAttributeMultiprocessorCount, dev);
        hipFuncSetAttribute((const void*)hyb_fwd, hipFuncAttributeMaxDynamicSharedMemorySize, LDS_BYTES);
        hipOccupancyMaxActiveBlocksPerMultiprocessor(&per_cu, (const void*)hyb_fwd, 512, LDS_BYTES);
        (void)hipGetLastError();
        if (per_cu < 1) { fprintf(stderr, "kernel_launch: occupancy query says %d blocks per CU\n", per_cu); per_cu = 1; }
        grid = cus;
    }
    if (grid < 0) return;
    hipMemsetAsync((char*)d_ws + WS_CTL, 0, 65536, stream);
    Args a{};
    a.x = (const float*)d_in[0]; a.norm_mix_g = (const float*)d_in[1]; a.w_in = (const float*)d_in[2]; a.ret_gn_g = (const float*)d_in[3]; a.w_ret_o = (const float*)d_in[4];
    a.q_norm_g = (const float*)d_in[5]; a.k_norm_g = (const float*)d_in[6]; a.sinks = (const float*)d_in[7]; a.w_swa_o = (const float*)d_in[8]; a.w_out = (const float*)d_in[9];
    a.norm_ffn_g = (const float*)d_in[10]; a.w_rg = (const float*)d_in[11]; a.b_rg = (const float*)d_in[12]; a.w_re = (const float*)d_in[13]; a.b_re = (const float*)d_in[14];
    a.w_gate = (const float*)d_in[15]; a.w_up = (const float*)d_in[16]; a.w_down = (const float*)d_in[17];
    a.out = (float*)d_out; a.ws = (unsigned char*)d_ws;
    void* args[] = {&a};
    hipError_t e = hipLaunchCooperativeKernel((const void*)hyb_fwd, dim3(grid), dim3(512), args, LDS_BYTES, stream);
    if (e != hipSuccess) fprintf(stderr, "cooperative launch failed: %s (grid %d)\n", hipGetErrorString(e), grid);
}
```
